# Optimizing an MI355X kernel written in HIP

```python
import math
import jax, jax.numpy as jnp
from jax import lax
import numpy as np

D_MODEL = 1024
BATCH = 8
SEQ = 2048
DEPTH = 2

PLE_DIM = 256
MIX_WIDTH = D_MODEL
GROUP_WIDTH = MIX_WIDTH // 4
CHUNK = 64
EPS = 1e-6

GLA_HEADS = 4
GLA_DK = GROUP_WIDTH // (2 * GLA_HEADS)
GLA_DV = GROUP_WIDTH // GLA_HEADS
GLA_RANK = 16
GLA_GATE_NORM = 16.0

S5_CH = 16
S5_GROUPS = GROUP_WIDTH // S5_CH
S5_STATE = 64
S5_DT_MIN = 1e-3
S5_DT_MAX = 1e-1

RET_HEADS = 4
RET_DK = GROUP_WIDTH // RET_HEADS
RET_DV = GROUP_WIDTH // RET_HEADS
ROPE_BASE = 10000.0

GDN_HEADS = 4
GDN_DK = GROUP_WIDTH // GDN_HEADS
GDN_DV = GROUP_WIDTH // GDN_HEADS
GDN_CONV = 4
GDN_DT_MIN = 1e-3
GDN_DT_MAX = 1e-1

FFN_HIDDEN = -(-8 * D_MODEL // (3 * 256)) * 256

IN_SPLITS = (
    GLA_HEADS * GLA_DK, GLA_HEADS * GLA_DK, GLA_HEADS * GLA_DV, GLA_RANK, GROUP_WIDTH,
    GROUP_WIDTH,
    RET_HEADS * RET_DK, RET_HEADS * RET_DK, RET_HEADS * RET_DV, GROUP_WIDTH,
    GDN_HEADS * GDN_DK, GDN_HEADS * GDN_DK, GDN_HEADS * GDN_DV, GDN_HEADS, GDN_HEADS, GROUP_WIDTH,
)
IN_WIDTH = sum(IN_SPLITS)

kernel_name = "hybrid_parallel_gla_s5_retnet_gdn"

F32 = jnp.float32


def rms_norm(x, g):
    xf = x.astype(F32)
    y = xf * lax.rsqrt(jnp.mean(xf * xf, axis=-1, keepdims=True) + EPS)
    return (y * g.astype(F32)).astype(x.dtype)


def head_rms_norm(x, g):
    return x * lax.rsqrt(jnp.mean(x * x, axis=-1, keepdims=True) + EPS) * g.astype(F32)


def l2_norm(x):
    return x * lax.rsqrt(jnp.sum(x * x, axis=-1, keepdims=True) + EPS)


def to_chunks(x):
    B, L, H, d = x.shape
    return x.reshape(B, L // CHUNK, CHUNK, H, d).transpose(0, 3, 1, 2, 4)


def from_chunks(x):
    B, H, nc, C, d = x.shape
    return x.transpose(0, 2, 3, 1, 4).reshape(B, nc * C, H, d)


def split_columns(z):
    offs = np.cumsum(IN_SPLITS)[:-1].tolist()
    return jnp.split(z, offs, axis=-1)


def scan_chunk_states(d_state, decay):
    ds = jnp.moveaxis(d_state, 2, 0)
    dc = jnp.moveaxis(decay, 2, 0)

    def step(S, inp):
        inc, a = inp
        return S * a + inc, S

    _, s_prev = lax.scan(step, jnp.zeros_like(ds[0]), (ds, dc))
    return jnp.moveaxis(s_prev, 0, 2)


def rope_tables(positions):
    inv_freq = ROPE_BASE ** (-jnp.linspace(0.0, 1.0, RET_DK // 2, dtype=F32))
    ang = positions.astype(F32)[..., None] * inv_freq
    return jnp.cos(ang)[:, :, None, :], jnp.sin(ang)[:, :, None, :]


def apply_rope(x, cos, sin):
    x1, x2 = jnp.split(x, 2, axis=-1)
    return jnp.concatenate([x1 * cos - x2 * sin, x1 * sin + x2 * cos], axis=-1)


def causal_depthwise_conv(x, w):
    K, C = w.shape
    return lax.conv_general_dilated(x, w[:, None, :], window_strides=(1,), padding=[(K - 1, 0)],
                                    dimension_numbers=("NWC", "WIO", "NWC"), feature_group_count=C)


def gla_mixer(q, k, v, a_low, r, w_a2, b_a, norm_g):
    B, L = q.shape[:2]
    q = q.astype(F32).reshape(B, L, GLA_HEADS, GLA_DK) * GLA_DK ** -0.5
    k = k.astype(F32).reshape(B, L, GLA_HEADS, GLA_DK)
    v = v.astype(F32).reshape(B, L, GLA_HEADS, GLA_DV)
    gk = jax.nn.log_sigmoid(a_low.astype(F32) @ w_a2.astype(F32) + b_a.astype(F32)) / GLA_GATE_NORM
    gk = gk.reshape(B, L, GLA_HEADS, GLA_DK)
    qc, kc, vc, gc = to_chunks(q), to_chunks(k), to_chunks(v), to_chunks(gk)
    b = jnp.cumsum(gc, axis=3)
    b_last = b[:, :, :, -1:, :]
    q_t = qc * jnp.exp(b)
    k_t = kc * jnp.exp(-b)
    k_end = kc * jnp.exp(b_last - b)
    causal = jnp.tril(jnp.ones((CHUNK, CHUNK), dtype=bool))
    attn = jnp.where(causal, jnp.einsum('bhncd,bhnsd->bhncs', q_t, k_t), 0.0)
    o = jnp.einsum('bhncs,bhnsv->bhncv', attn, vc)
    d_state = jnp.einsum('bhnsd,bhnsv->bhndv', k_end, vc)
    s_prev = scan_chunk_states(d_state, jnp.swapaxes(jnp.exp(b_last), -1, -2))
    o = o + jnp.einsum('bhncd,bhndv->bhncv', q_t, s_prev)
    o = head_rms_norm(from_chunks(o), norm_g)
    return o.reshape(B, L, GLA_HEADS * GLA_DV) * jax.nn.silu(r.astype(F32))


def s5_mixer(u, lam_re, lam_im, log_dt, b_re, b_im, c_re, c_im, d_skip, w_glu, b_glu):
    B, L, _ = u.shape
    uf = u.astype(F32).reshape(B, L, S5_GROUPS, S5_CH)
    lam = lax.complex(jnp.minimum(lam_re.astype(F32), -1e-4), lam_im.astype(F32))
    dt = jnp.exp(log_dt.astype(F32))[:, None]
    a_bar = jnp.exp(lam * dt)
    b_bar = ((a_bar - 1.0) / lam)[..., None] * lax.complex(b_re.astype(F32), b_im.astype(F32))
    bu = jnp.einsum('blgh,gph->blgp', uf, b_bar)
    a_elems = jnp.broadcast_to(a_bar, (L,) + a_bar.shape)[None]

    def combine(e1, e2):
        a1, s1 = e1
        a2, s2 = e2
        return a2 * a1, a2 * s1 + s2

    _, states = lax.associative_scan(combine, (a_elems, bu), axis=1)
    c = lax.complex(c_re.astype(F32), c_im.astype(F32))
    y = jnp.real(jnp.einsum('blgp,ghp->blgh', states, c)) + d_skip.astype(F32).reshape(S5_GROUPS, S5_CH) * uf
    y = jax.nn.gelu(y.reshape(B, L, GROUP_WIDTH))
    return y * jax.nn.sigmoid(y @ w_glu.astype(F32) + b_glu.astype(F32))


def retention_mixer(q, k, v, g, cos, sin, norm_g):
    B, L = q.shape[:2]
    q = apply_rope(q.astype(F32).reshape(B, L, RET_HEADS, RET_DK), cos, sin)
    k = apply_rope(k.astype(F32).reshape(B, L, RET_HEADS, RET_DK), cos, sin) * RET_DK ** -0.5
    v = v.astype(F32).reshape(B, L, RET_HEADS, RET_DV)
    log_gamma = jnp.log1p(-(2.0 ** (-5.0 - jnp.arange(RET_HEADS, dtype=F32))))
    qc, kc, vc = to_chunks(q), to_chunks(k), to_chunks(v)
    nc = qc.shape[2]
    idx = jnp.arange(CHUNK, dtype=F32)
    rel = idx[:, None] - idx[None, :]
    dmask = jnp.where(rel >= 0, jnp.exp(jnp.maximum(rel, 0.0) * log_gamma[:, None, None]), 0.0)
    inner = jnp.einsum('bhncs,bhnsv->bhncv', jnp.einsum('bhncd,bhnsd->bhncs', qc, kc) * dmask[None, :, None], vc)
    xi = jnp.exp((idx + 1.0) * log_gamma[:, None])
    zeta = jnp.exp((CHUNK - 1.0 - idx) * log_gamma[:, None])
    d_state = jnp.einsum('bhnsd,bhnsv->bhndv', kc * zeta[None, :, None, :, None], vc)
    chunk_decay = jnp.broadcast_to(jnp.exp(CHUNK * log_gamma)[None, :, None, None, None], (B, RET_HEADS, nc, 1, 1))
    s_prev = scan_chunk_states(d_state, chunk_decay)
    cross = jnp.einsum('bhncd,bhndv->bhncv', qc, s_prev) * xi[None, :, None, :, None]
    o = from_chunks(inner + cross)
    o = o - jnp.mean(o, axis=-1, keepdims=True)
    o = o * lax.rsqrt(jnp.mean(o * o, axis=-1, keepdims=True) + EPS)
    o = o.reshape(B, L, RET_HEADS * RET_DV) * norm_g.astype(F32)
    return o * jax.nn.silu(g.astype(F32))


def gdn_mixer(q, k, v, beta_raw, a_raw, gate, conv_w, a_log, dt_bias, norm_g):
    B, L = q.shape[:2]
    qkv = jnp.concatenate([q, k, v], axis=-1).astype(F32)
    qkv = jax.nn.silu(causal_depthwise_conv(qkv, conv_w.astype(F32)))
    nq = GDN_HEADS * GDN_DK
    q, k, v = qkv[..., :nq], qkv[..., nq:2 * nq], qkv[..., 2 * nq:]
    q = l2_norm(q.reshape(B, L, GDN_HEADS, GDN_DK)) * GDN_DK ** -0.5
    k = l2_norm(k.reshape(B, L, GDN_HEADS, GDN_DK))
    v = v.reshape(B, L, GDN_HEADS, GDN_DV)
    beta = jax.nn.sigmoid(beta_raw.astype(F32))
    g = -jnp.exp(a_log.astype(F32)) * jax.nn.softplus(a_raw.astype(F32) + dt_bias.astype(F32))
    qc, kc, vc = to_chunks(q), to_chunks(k), to_chunks(v)
    bc = to_chunks(beta[..., None])[..., 0]
    gcum = jnp.cumsum(to_chunks(g[..., None])[..., 0], axis=-1)
    pos = jnp.arange(CHUNK)
    incl = pos[:, None] >= pos[None, :]
    strict = pos[:, None] > pos[None, :]
    diff = gcum[..., :, None] - gcum[..., None, :]
    decay_incl = jnp.exp(jnp.where(incl, diff, -jnp.inf))
    kk = jnp.einsum('bhncd,bhnsd->bhncs', kc, kc)
    a_mat = jnp.where(strict, kk * decay_incl, 0.0) * bc[..., :, None]
    rhs = jnp.concatenate([vc * bc[..., None], kc * (bc * jnp.exp(gcum))[..., None]], axis=-1)
    sol = lax.linalg.triangular_solve(a_mat, rhs, left_side=True, lower=True, unit_diagonal=True)
    u_c, w_c = sol[..., :GDN_DV], sol[..., GDN_DV:]
    aqk = jnp.einsum('bhncd,bhnsd->bhncs', qc, kc) * decay_incl
    q_dec = qc * jnp.exp(gcum)[..., None]
    k_end = kc * jnp.exp(gcum[..., -1:] - gcum)[..., None]
    dec_last = jnp.exp(gcum[..., -1])
    xs = tuple(jnp.moveaxis(t, 2, 0) for t in (u_c, w_c, q_dec, aqk, k_end, dec_last))

    def step(S, inp):
        u_i, w_i, qd_i, a_i, ke_i, dl_i = inp
        v_new = u_i - jnp.einsum('bhck,bhkv->bhcv', w_i, S)
        o_i = jnp.einsum('bhck,bhkv->bhcv', qd_i, S) + jnp.einsum('bhcs,bhsv->bhcv', a_i, v_new)
        S = S * dl_i[..., None, None] + jnp.einsum('bhck,bhcv->bhkv', ke_i, v_new)
        return S, o_i

    s0 = jnp.zeros((B, GDN_HEADS, GDN_DK, GDN_DV), F32)
    _, o = lax.scan(step, s0, xs)
    o = head_rms_norm(from_chunks(jnp.moveaxis(o, 0, 2)), norm_g)
    return o.reshape(B, L, GDN_HEADS * GDN_DV) * jax.nn.silu(gate.astype(F32))


def swiglu(x, w_up, w_down):
    gu = x @ w_up
    g, u = jnp.split(gu, 2, axis=-1)
    return (jax.nn.silu(g) * u) @ w_down


def setup_inputs(seed: int = 0) -> dict:
    key = jax.random.key(seed)
    ks = jax.random.split(key, 32)
    nrm = jax.random.normal

    def gain(k, shape):
        return 1.0 + 0.02 * nrm(k, shape, F32)

    x = nrm(ks[0], (BATCH, SEQ, D_MODEL), F32)
    p = nrm(ks[1], (DEPTH, BATCH, SEQ, PLE_DIM), F32)
    positions = jnp.arange(SEQ, dtype=jnp.int32)[None, :] + jax.random.randint(ks[2], (BATCH, 1), 0, SEQ, dtype=jnp.int32)
    norm_mix = gain(ks[3], (DEPTH, D_MODEL))
    w_in = nrm(ks[4], (DEPTH, D_MODEL, IN_WIDTH), F32) * D_MODEL ** -0.5
    w_out = nrm(ks[5], (DEPTH, MIX_WIDTH, D_MODEL), F32) * MIX_WIDTH ** -0.5
    gla_w_a2 = nrm(ks[6], (DEPTH, GLA_RANK, GLA_HEADS * GLA_DK), F32) * GLA_RANK ** -0.5
    gla_b_a = 0.1 * nrm(ks[7], (DEPTH, GLA_HEADS * GLA_DK), F32)
    gla_norm = gain(ks[8], (DEPTH, GLA_DV))
    s5_lam_re = -0.5 + 0.01 * nrm(ks[9], (DEPTH, S5_GROUPS, S5_STATE), F32)
    s5_lam_im = math.pi * jnp.arange(S5_STATE, dtype=F32) + 0.01 * nrm(ks[10], (DEPTH, S5_GROUPS, S5_STATE), F32)
    s5_log_dt = jax.random.uniform(ks[11], (DEPTH, S5_GROUPS), F32, math.log(S5_DT_MIN), math.log(S5_DT_MAX))
    s5_b_re = nrm(ks[12], (DEPTH, S5_GROUPS, S5_STATE, S5_CH), F32) * (2 * S5_CH) ** -0.5
    s5_b_im = nrm(ks[13], (DEPTH, S5_GROUPS, S5_STATE, S5_CH), F32) * (2 * S5_CH) ** -0.5
    s5_c_re = nrm(ks[14], (DEPTH, S5_GROUPS, S5_CH, S5_STATE), F32) * S5_STATE ** -0.5
    s5_c_im = nrm(ks[15], (DEPTH, S5_GROUPS, S5_CH, S5_STATE), F32) * S5_STATE ** -0.5
    s5_d = nrm(ks[16], (DEPTH, GROUP_WIDTH), F32)
    s5_w_glu = nrm(ks[17], (DEPTH, GROUP_WIDTH, GROUP_WIDTH), F32) * GROUP_WIDTH ** -0.5
    s5_b_glu = 0.01 * nrm(ks[18], (DEPTH, GROUP_WIDTH), F32)
    ret_norm = gain(ks[19], (DEPTH, GROUP_WIDTH))
    gdn_conv = nrm(ks[20], (DEPTH, GDN_CONV, 3 * GDN_HEADS * GDN_DK), F32) * GDN_CONV ** -0.5
    gdn_a_log = jnp.log(jax.random.uniform(ks[21], (DEPTH, GDN_HEADS), F32, 1.0, 16.0))
    dt = jnp.exp(jax.random.uniform(ks[22], (DEPTH, GDN_HEADS), F32, math.log(GDN_DT_MIN), math.log(GDN_DT_MAX)))
    gdn_dt_bias = dt + jnp.log(-jnp.expm1(-dt))
    gdn_norm = gain(ks[23], (DEPTH, GDN_DV))
    norm_ffn = gain(ks[24], (DEPTH, D_MODEL))
    w_ffn_up = nrm(ks[25], (DEPTH, D_MODEL, 2 * FFN_HIDDEN), F32) * D_MODEL ** -0.5
    w_ffn_down = nrm(ks[26], (DEPTH, FFN_HIDDEN, D_MODEL), F32) * FFN_HIDDEN ** -0.5
    norm_ple = gain(ks[27], (DEPTH, D_MODEL))
    w_ple_gate = nrm(ks[28], (DEPTH, D_MODEL, D_MODEL), F32) * D_MODEL ** -0.5
    w_ple_proj = nrm(ks[29], (DEPTH, PLE_DIM, D_MODEL), F32) * PLE_DIM ** -0.5
    norm_final = gain(ks[30], (D_MODEL,))
    return {"x": x, "p": p, "positions": positions, "norm_mix": norm_mix, "w_in": w_in, "w_out": w_out,
            "gla_w_a2": gla_w_a2, "gla_b_a": gla_b_a, "gla_norm": gla_norm,
            "s5_lam_re": s5_lam_re, "s5_lam_im": s5_lam_im, "s5_log_dt": s5_log_dt,
            "s5_b_re": s5_b_re, "s5_b_im": s5_b_im, "s5_c_re": s5_c_re, "s5_c_im": s5_c_im,
            "s5_d": s5_d, "s5_w_glu": s5_w_glu, "s5_b_glu": s5_b_glu, "ret_norm": ret_norm,
            "gdn_conv": gdn_conv, "gdn_a_log": gdn_a_log, "gdn_dt_bias": gdn_dt_bias, "gdn_norm": gdn_norm,
            "norm_ffn": norm_ffn, "w_ffn_up": w_ffn_up, "w_ffn_down": w_ffn_down,
            "norm_ple": norm_ple, "w_ple_gate": w_ple_gate, "w_ple_proj": w_ple_proj, "norm_final": norm_final}


def reference(x, p, positions, norm_mix, w_in, w_out, gla_w_a2, gla_b_a, gla_norm,
              s5_lam_re, s5_lam_im, s5_log_dt, s5_b_re, s5_b_im, s5_c_re, s5_c_im,
              s5_d, s5_w_glu, s5_b_glu, ret_norm, gdn_conv, gdn_a_log, gdn_dt_bias, gdn_norm,
              norm_ffn, w_ffn_up, w_ffn_down, norm_ple, w_ple_gate, w_ple_proj, norm_final):
    cos, sin = rope_tables(positions)
    h = x
    for i in range(DEPTH):
        hn = rms_norm(h, norm_mix[i])
        z = hn @ w_in[i]
        (aq, ak, av, a_low, ar, su, rq, rk, rv, rg, dq, dk, dv, db, da, dg) = split_columns(z)
        o_a = gla_mixer(aq, ak, av, a_low, ar, gla_w_a2[i], gla_b_a[i], gla_norm[i])
        o_b = s5_mixer(su, s5_lam_re[i], s5_lam_im[i], s5_log_dt[i], s5_b_re[i], s5_b_im[i],
                       s5_c_re[i], s5_c_im[i], s5_d[i], s5_w_glu[i], s5_b_glu[i])
        o_c = retention_mixer(rq, rk, rv, rg, cos, sin, ret_norm[i])
        o_d = gdn_mixer(dq, dk, dv, db, da, dg, gdn_conv[i], gdn_a_log[i], gdn_dt_bias[i], gdn_norm[i])
        mix = jnp.concatenate([o_a, o_b, o_c, o_d], axis=-1).astype(h.dtype)
        h = h + mix @ w_out[i]
        h = h + swiglu(rms_norm(h, norm_ffn[i]), w_ffn_up[i], w_ffn_down[i])
        ple_gate = jax.nn.sigmoid(rms_norm(h, norm_ple[i]) @ w_ple_gate[i])
        h = h + (p[i] @ w_ple_proj[i]) * ple_gate
    return rms_norm(h, norm_final)
```

```cpp
#include <hip/hip_runtime.h>
#include <hip/hip_cooperative_groups.h>
#include <cstdio>
namespace cg = cooperative_groups;

#define LAS __attribute__((address_space(3)))
#define GAS __attribute__((address_space(1)))
typedef unsigned short bf16_t;
typedef short bf16x8 __attribute__((ext_vector_type(8)));
typedef float f32x4 __attribute__((ext_vector_type(4)));
typedef float f32x2 __attribute__((ext_vector_type(2)));
typedef unsigned u32x4 __attribute__((ext_vector_type(4)));
typedef unsigned u32x2 __attribute__((ext_vector_type(2)));

constexpr int MTOK = 16384, DM = 1024, SEQL = 2048, NCH = 32, NZ = 3072, INW = 3096, FF = 2816, NUP = 5632, PLED = 256;
constexpr float EPSF = 1e-6f;
constexpr int NTHR = 512;
constexpr int LDS_BYTES = 147456;
constexpr int ZC_AV = 0, ZC_SU = 256, ZC_RV = 512, ZC_DV = 768, ZC_AQ = 1024, ZC_AK = 1152, ZC_AR = 1280, ZC_RQ = 1536, ZC_RK = 1792, ZC_RG = 2048, ZC_DQ = 2304, ZC_DK = 2560, ZC_DG = 2816;

constexpr size_t al256(size_t x) { return (x + 255) & ~(size_t)255; }
constexpr size_t WS_WIN = 0;
constexpr size_t WS_WSM = WS_WIN + (size_t)NZ * DM * 2;
constexpr size_t WS_WOUT = WS_WSM + (size_t)32 * DM * 2;
constexpr size_t WS_WUP = WS_WOUT + (size_t)DM * DM * 2;
constexpr size_t WS_WDN = WS_WUP + (size_t)NUP * DM * 2;
constexpr size_t WS_WPG = WS_WDN + (size_t)DM * FF * 2;
constexpr size_t WS_WPP = WS_WPG + (size_t)DM * DM * 2;
constexpr size_t WS_WGLU = WS_WPP + (size_t)DM * PLED * 2;
constexpr size_t WS_S5A = WS_WGLU + (size_t)256 * 256 * 2;
constexpr size_t WS_S5BB = WS_S5A + 4 * 1024 * 4;
constexpr size_t WS_HB = WS_S5BB + (size_t)16 * 64 * 32 * 4;
constexpr size_t WS_ROWSS = WS_HB + (size_t)MTOK * DM * 2;
constexpr size_t WS_ZS = WS_ROWSS + (size_t)7 * MTOK * 8;
constexpr size_t WS_GDL = WS_ZS + (size_t)MTOK * 32 * 4;
constexpr size_t WS_GLDEC = WS_GDL + 1024 * 4;
constexpr size_t WS_BIG = al256(WS_GLDEC + 1024 * 32 * 4);
constexpr size_t WS_Z = WS_BIG;
constexpr size_t WS_GU = WS_Z + (size_t)MTOK * NZ * 2;
constexpr size_t WS_GW = WS_GU + (size_t)1024 * 4096 * 4;
constexpr size_t WS_GA = WS_GW + (size_t)1024 * 4096 * 4;
constexpr size_t WS_GQD = WS_GA + (size_t)1024 * 4096 * 4;
constexpr size_t WS_GKE = WS_GQD + (size_t)1024 * 4096 * 2;
constexpr size_t WS_RDS = WS_GKE + (size_t)1024 * 4096 * 2;
constexpr size_t WS_ADS = WS_RDS + (size_t)1024 * 4096 * 4;
constexpr size_t WS_S5E = WS_ADS + (size_t)1024 * 2048 * 4;
constexpr size_t WS_END = WS_S5E + (size_t)8 * 16 * 32 * 64 * 8;
constexpr size_t WS_BAR = al256(WS_END);
constexpr size_t WS_TOTAL = WS_BAR + 16384;
constexpr size_t WS_ACT = WS_BIG;
constexpr size_t WS_PB = WS_BIG + (size_t)100663296;
constexpr size_t WS_TMP = WS_BIG;
constexpr size_t WS_HB2 = WS_BIG + (size_t)115343360;
static_assert(WS_PB + (size_t)MTOK * PLED * 2 <= WS_HB2 && WS_HB2 + (size_t)MTOK * DM * 2 <= WS_END, "hb2 placement");
static_assert((size_t)MTOK * FF * 2 <= 100663296, "act fits under PB");
static_assert(WS_PB + (size_t)MTOK * PLED * 2 <= WS_END, "pb inside");

struct Params {
    const float* in[31];
    float* out;
    unsigned char* ws;
};
enum { I_X = 0, I_P, I_POS, I_NMIX, I_WIN, I_WOUT, I_GLA_WA2, I_GLA_BA, I_GLA_NORM, I_S5_LRE, I_S5_LIM, I_S5_LOGDT, I_S5_BRE, I_S5_BIM, I_S5_CRE, I_S5_CIM,
       I_S5_D, I_S5_WGLU, I_S5_BGLU, I_RET_NORM, I_GDN_CONV, I_GDN_ALOG, I_GDN_DTB, I_GDN_NORM, I_NFFN, I_WUP, I_WDN, I_NPLE, I_WPG, I_WPP, I_NFINAL };

__device__ __forceinline__ unsigned f2bf(float f) { unsigned u = __builtin_bit_cast(unsigned, f); return (u + 0x7fffu + ((u >> 16) & 1u)) >> 16; }
__device__ __forceinline__ unsigned pk2(float lo, float hi) { return f2bf(lo) | (f2bf(hi) << 16); }
__device__ __forceinline__ float bf_lo(unsigned w) { return __builtin_bit_cast(float, w << 16); }
__device__ __forceinline__ float bf_hi(unsigned w) { return __builtin_bit_cast(float, w & 0xffff0000u); }
__device__ __forceinline__ float bf2f(bf16_t v) { return __builtin_bit_cast(float, ((unsigned)v) << 16); }
__device__ __forceinline__ void unpack8(u32x4 w, float* v) { v[0] = bf_lo(w.x); v[1] = bf_hi(w.x); v[2] = bf_lo(w.y); v[3] = bf_hi(w.y); v[4] = bf_lo(w.z); v[5] = bf_hi(w.z); v[6] = bf_lo(w.w); v[7] = bf_hi(w.w); }
__device__ __forceinline__ u32x4 pack8(const float* v) { u32x4 w; w.x = pk2(v[0], v[1]); w.y = pk2(v[2], v[3]); w.z = pk2(v[4], v[5]); w.w = pk2(v[6], v[7]); return w; }
__device__ __forceinline__ float sigm(float x) { return 1.f / (1.f + __expf(-x)); }
__device__ __forceinline__ float siluf(float x) { return x / (1.f + __expf(-x)); }
__device__ __forceinline__ float softplusf(float x) { return fmaxf(x, 0.f) + __logf(1.f + __expf(-fabsf(x))); }
__device__ __forceinline__ float gelu_tanh(float y) { float t = 0.7978845608028654f * (y + 0.044715f * y * y * y); float e = __expf(2.f * t); float th = 1.f - 2.f / (e + 1.f); return 0.5f * y * (1.f + th); }
__device__ __forceinline__ void sincos_d(double a, float& s, float& c) {
    double kd = rint(a * 0.6366197723675814); float r = (float)(a - kd * 1.5707963267948966);
    int q = ((int)(long long)kd) & 3; float r2 = r * r;
    float sn = r + r * r2 * (-1.6666667e-1f + r2 * (8.3333333e-3f + r2 * (-1.9841270e-4f + r2 * 2.7557319e-6f)));
    float cs = 1.f + r2 * (-0.5f + r2 * (4.1666667e-2f + r2 * (-1.3888889e-3f + r2 * 2.4801587e-5f)));
    float s0 = (q & 1) ? cs : sn, c0 = (q & 1) ? sn : cs;
    s = (q & 2) ? -s0 : s0; c = (q == 1 || q == 2) ? -c0 : c0;
}
#define LBAR() do { asm volatile("s_waitcnt lgkmcnt(0)" ::: "memory"); __builtin_amdgcn_s_barrier(); asm volatile("" ::: "memory"); } while (0)
__device__ __forceinline__ int ltid() { int t = threadIdx.x; asm volatile("" : "+v"(t)); return t; }
__device__ __forceinline__ int lsg(int x) { asm volatile("" : "+s"(x)); return x; }
typedef unsigned u64_t;
constexpr float SS_SCALE = 64.f, SS_INV = 1.f / (64.f * DM);
__device__ __forceinline__ float row_rs(const float* rowss, int row) { const u64_t v = ((const GAS u64_t*)rowss)[row]; return rsqrtf((float)v * SS_INV + EPSF); }
__device__ __forceinline__ void row_ss_add(float* rowss, int row, float ss) { __hip_atomic_fetch_add((GAS u64_t*)rowss + row, (u64_t)(ss * SS_SCALE + 0.5f), __ATOMIC_RELAXED, __HIP_MEMORY_SCOPE_AGENT); }
__device__ __forceinline__ f32x4 mm16(const float* A, int ars, int aks, const float* B, int bks, int bcs, int K, f32x4 acc, int lane) {
    const float* ap = A + (lane & 15) * ars + (lane >> 4) * aks;
    const float* bp = B + (lane >> 4) * bks + (lane & 15) * bcs;
    f32x4 acc2 = {0.f, 0.f, 0.f, 0.f}; const int Kh = K >> 1;
#pragma unroll 2
    for (int k = 0; k < Kh; k += 4) { acc = __builtin_amdgcn_mfma_f32_16x16x4f32(ap[k * aks], bp[k * bks], acc, 0, 0, 0);
        acc2 = __builtin_amdgcn_mfma_f32_16x16x4f32(ap[(k + Kh) * aks], bp[(k + Kh) * bks], acc2, 0, 0, 0); }
    return acc + acc2;
}
template <bool BC>
__device__ __forceinline__ f32x4 mm16v(const float* A, int ap, const float* B, int bp, int K, f32x4 acc, int lane) {
    const int i = lane & 15, q = lane >> 4;
    const float* apn = A + i * ap + 4 * q;
    const float* bpn = BC ? (B + i * bp + 4 * q) : (B + (4 * q) * bp + i);
    f32x4 acc2 = {0.f, 0.f, 0.f, 0.f};
#pragma unroll 2
    for (int c = 0; c < K; c += 16) {
        const f32x4 a4 = *(const f32x4*)(apn + c);
        f32x4 b4;
        if (BC) b4 = *(const f32x4*)(bpn + c);
        else { b4[0] = bpn[c * bp]; b4[1] = bpn[(c + 1) * bp]; b4[2] = bpn[(c + 2) * bp]; b4[3] = bpn[(c + 3) * bp]; }
        if (c & 16) {
#pragma unroll
            for (int e = 0; e < 4; ++e) acc2 = __builtin_amdgcn_mfma_f32_16x16x4f32(a4[e], b4[e], acc2, 0, 0, 0);
        } else {
#pragma unroll
            for (int e = 0; e < 4; ++e) acc = __builtin_amdgcn_mfma_f32_16x16x4f32(a4[e], b4[e], acc, 0, 0, 0);
        }
    }
    return acc + acc2;
}
template <bool BC>
__device__ __forceinline__ void mm16v2(const float* A, int ap, const float* B, int bp, int K, f32x4& acc0, f32x4& acc1, int lane) {
    const int i = lane & 15, q = lane >> 4;
    const float* apn = A + i * ap + 4 * q;
    const float* bpn = BC ? (B + (2 * i) * bp + 4 * q) : (B + (4 * q) * bp + 2 * i);
#pragma unroll 2
    for (int c = 0; c < K; c += 16) {
        const f32x4 a4 = *(const f32x4*)(apn + c);
        if (BC) { const f32x4 x0 = *(const f32x4*)(bpn + c), x1 = *(const f32x4*)(bpn + bp + c);
#pragma unroll
            for (int e = 0; e < 4; ++e) { acc0 = __builtin_amdgcn_mfma_f32_16x16x4f32(a4[e], x0[e], acc0, 0, 0, 0); acc1 = __builtin_amdgcn_mfma_f32_16x16x4f32(a4[e], x1[e], acc1, 0, 0, 0); } }
        else { f32x2 bb[4];
#pragma unroll
            for (int e = 0; e < 4; ++e) bb[e] = *(const f32x2*)(bpn + (c + e) * bp);
#pragma unroll
            for (int e = 0; e < 4; ++e) { acc0 = __builtin_amdgcn_mfma_f32_16x16x4f32(a4[e], bb[e][0], acc0, 0, 0, 0); acc1 = __builtin_amdgcn_mfma_f32_16x16x4f32(a4[e], bb[e][1], acc1, 0, 0, 0); } }
    }
}
__device__ __forceinline__ void mm16t2(const float* A, int ap, const float* B, int bp, int K, f32x4& acc0, f32x4& acc1, int lane) {
    const int i = lane & 15, q = lane >> 4;
    const float* apn = A + (4 * q) * ap + i; const float* bpn = B + (4 * q) * bp + 2 * i;
#pragma unroll 2
    for (int c = 0; c < K; c += 16) { float a4[4]; f32x2 bb[4];
#pragma unroll
        for (int e = 0; e < 4; ++e) { a4[e] = apn[(c + e) * ap]; bb[e] = *(const f32x2*)(bpn + (c + e) * bp); }
#pragma unroll
        for (int e = 0; e < 4; ++e) { acc0 = __builtin_amdgcn_mfma_f32_16x16x4f32(a4[e], bb[e][0], acc0, 0, 0, 0); acc1 = __builtin_amdgcn_mfma_f32_16x16x4f32(a4[e], bb[e][1], acc1, 0, 0, 0); } }
}
__device__ __forceinline__ void ld_tile64(float* dst, const bf16_t* src, size_t pitch, int tid) {
    const int r = tid >> 3, c8 = (tid & 7) * 8; float v[8];
    unpack8(*(const u32x4*)(src + (size_t)r * pitch + c8), v);
    float* d = dst + r * 68 + c8;
    *(f32x4*)d = (f32x4){v[0], v[1], v[2], v[3]}; *(f32x4*)(d + 4) = (f32x4){v[4], v[5], v[6], v[7]};
}
__device__ __forceinline__ u32x4 ldg_tile64(const bf16_t* src, size_t pitch, int tid) { return *(const u32x4*)(src + (size_t)(tid >> 3) * pitch + (tid & 7) * 8); }
__device__ __forceinline__ void st_tile64(float* dst, u32x4 w, int tid) { const int r = tid >> 3, c8 = (tid & 7) * 8; float v[8]; unpack8(w, v); float* d = dst + r * 68 + c8;
    *(f32x4*)d = (f32x4){v[0], v[1], v[2], v[3]}; *(f32x4*)(d + 4) = (f32x4){v[4], v[5], v[6], v[7]}; }
__device__ __forceinline__ u32x4 ldg_tile64x32(const bf16_t* src, int tid) { const int t = tid & 255; return *(const u32x4*)(src + (size_t)(t >> 2) * NZ + (t & 3) * 8); }
__device__ __forceinline__ void st_tile64x32(float* dst, u32x4 w, int tid) { if (tid < 256) { const int r = tid >> 2, c8 = (tid & 3) * 8; float v[8]; unpack8(w, v); float* d = dst + r * 36 + c8;
    *(f32x4*)d = (f32x4){v[0], v[1], v[2], v[3]}; *(f32x4*)(d + 4) = (f32x4){v[4], v[5], v[6], v[7]}; } }
__device__ __forceinline__ void ld_tile64f(float* dst, const float* src, int tid) {
    const int r = tid >> 3, c8 = (tid & 7) * 8;
    f32x4 a = *(const f32x4*)(src + r * 64 + c8), b = *(const f32x4*)(src + r * 64 + c8 + 4);
    *(f32x4*)(dst + r * 68 + c8) = a; *(f32x4*)(dst + r * 68 + c8 + 4) = b;
}

namespace pg8 {
constexpr int BM = 256, BK = 64, HALF = 128, HTB = HALF * BK * 2, NXCD = 8, WGM = 8;
__device__ __forceinline__ int lds_byte(int r, int c) { const int st = (r >> 4) * 2 + (c >> 5), rr = r & 15, cc = c & 31, ob = rr * 64 + cc * 2; return st * 1024 + (ob ^ (((ob >> 9) & 1) << 5)); }
__device__ __forceinline__ void stage_rc(int b, int& R, int& C) { const int st = b / 1024, sb = b % 1024, swz = sb ^ (((sb >> 9) & 1) << 5); R = (st >> 1) * 16 + swz / 64; C = (st & 1) * 32 + (swz % 64) / 2; }
__device__ __forceinline__ int perm32(int rho) { const int n = rho >> 4, i = rho & 15; return 8 * (i >> 2) + 4 * n + (i & 3); }
struct Unit { int pm, pn; };
struct Gemm { const bf16_t* A; const bf16_t* Bt; int M, N, K, lda; };
struct StaticOrder {
    int nM, nN, nwg, G, c;
    __device__ void init(int M, int N, int G_, int c_) { nM = M / BM; nN = N / BM; nwg = nM * nN; G = G_; c = c_; }
    __device__ bool next(int i, Unit& u) const {
        const long L = (long)i * G + c; if (L >= nwg) return false;
        int wgid = (int)L; { const int q = nwg / NXCD, r = nwg % NXCD, xcd = wgid % NXCD, off = wgid / NXCD; wgid = (xcd < r ? xcd * (q + 1) : r * (q + 1) + (xcd - r) * q) + off; }
        const int nig = WGM * nN, gid = wgid / nig, fm = gid * WGM, gsz = (nM - fm) < WGM ? (nM - fm) : WGM;
        u.pm = fm + ((wgid % nig) % gsz); u.pn = (wgid % nig) / gsz; return true;
    }
};

template <class Epi>
__device__ __forceinline__ void gemm_phase(LAS unsigned char* lds, const Gemm g, const StaticOrder& S, const Epi& E) {
    const int tid = ltid(), wid = __builtin_amdgcn_readfirstlane(tid >> 6), lane = tid & 63, wr = wid >> 2, wc = wid & 3, fr = lane & 15, fq = lane >> 4;
    const int K = g.K, nt = K / BK, lda = g.lda;
    unsigned voffA[2], voffB[2];
#pragma unroll
    for (int i = 0; i < 2; ++i) { int R, C; stage_rc(tid * 16 + i * 8192, R, C); const int Rb = Epi::PERM ? ((R & ~31) + perm32(R & 31)) : R;
        voffA[i] = (unsigned)(R * lda + C) * 2u; voffB[i] = (unsigned)(Rb * K + C) * 2u; }
    const size_t kstep = (size_t)(BK * 2);
    const size_t hstepA = (size_t)HALF * lda * 2, hstepB = (size_t)HALF * K * 2;
    const size_t tstepA = 2 * hstepA, tstepB = 2 * hstepB;
    const unsigned ldsw = (unsigned)wid * 1024u;
    const int aoff = lds_byte(wr * 64 + fr, fq * 8), boff = lds_byte(wc * 32 + fr, fq * 8);
#define PG8_SA(b, h) (((b) * 2 + (h)) * HTB)
#define PG8_SB(b, h) ((4 + (b) * 2 + (h)) * HTB)
#define PG8_STAGE(bufoff, gbase, voff) do { _Pragma("unroll") for (int _i = 0; _i < 2; ++_i) \
        __builtin_amdgcn_global_load_lds((const unsigned*)((const char*)(gbase) + (voff)[_i]), (LAS unsigned*)(lds + (bufoff) + ldsw + _i * 8192), 16, 0, 0); } while (0)
#define PG8_LDA(dst, b, h) do { _Pragma("unroll") for (int m = 0; m < 4; ++m) _Pragma("unroll") for (int k = 0; k < 2; ++k) dst[m][k] = *(const LAS bf16x8*)(lds + PG8_SA(b, h) + aoff + m * 2048 + k * 1024); } while (0)
#define PG8_LDB(dst, b, h) do { _Pragma("unroll") for (int n = 0; n < 2; ++n) _Pragma("unroll") for (int k = 0; k < 2; ++k) dst[n][k] = *(const LAS bf16x8*)(lds + PG8_SB(b, h) + boff + n * 2048 + k * 1024); } while (0)
#define PG8_MMA(ai, bj, At, Bt) do { __builtin_amdgcn_s_setprio(1); _Pragma("unroll") for (int m = 0; m < 4; ++m) _Pragma("unroll") for (int n = 0; n < 2; ++n) _Pragma("unroll") for (int k = 0; k < 2; ++k) \
        acc[ai][bj][m][n] = __builtin_amdgcn_mfma_f32_16x16x32_bf16(Bt[n][k], At[m][k], acc[ai][bj][m][n], 0, 0, 0); __builtin_amdgcn_s_setprio(0); } while (0)
#define PG8_WAIT_V(n) asm volatile("s_waitcnt vmcnt(" #n ")" ::: "memory")
#define PG8_WAIT_L(n) asm volatile("s_waitcnt lgkmcnt(" #n ")" ::: "memory")
#define PG8_BAR __builtin_amdgcn_s_barrier()
#define PG8_SCHED __builtin_amdgcn_sched_barrier(0)
    Unit cur, nxt; int ui = 0;
    if (!S.next(0, cur)) return;
    f32x4 acc[2][2][4][2];
#pragma unroll
    for (int a = 0; a < 2; ++a)
#pragma unroll
        for (int b = 0; b < 2; ++b)
#pragma unroll
            for (int m = 0; m < 4; ++m)
#pragma unroll
                for (int n = 0; n < 2; ++n) acc[a][b][m][n] = (f32x4){0.f, 0.f, 0.f, 0.f};
    bf16x8 At[4][2], B0[2][2], B1[2][2];
    const char* cA = (const char*)g.A + (size_t)cur.pm * tstepA; const char* cB = (const char*)g.Bt + (size_t)cur.pn * tstepB;
    PG8_STAGE(PG8_SB(0, 0), cB, voffB); PG8_STAGE(PG8_SA(0, 0), cA, voffA); PG8_STAGE(PG8_SB(0, 1), cB + hstepB, voffB); PG8_STAGE(PG8_SA(0, 1), cA + hstepA, voffA);
    if (wr == 1) PG8_BAR;
    PG8_WAIT_V(4); PG8_BAR;
    PG8_STAGE(PG8_SB(1, 0), cB + kstep, voffB); PG8_STAGE(PG8_SA(1, 0), cA + kstep, voffA); PG8_STAGE(PG8_SB(1, 1), cB + hstepB + kstep, voffB);
    PG8_WAIT_V(6); PG8_BAR;
    for (;;) {
        const bool has_next = S.next(ui + 1, nxt);
        const char* nA = has_next ? (const char*)g.A + (size_t)nxt.pm * tstepA : cA; const char* nB = has_next ? (const char*)g.Bt + (size_t)nxt.pn * tstepB : cB;
        for (int t = 0; t < nt; t += 2) {
            const bool last = (t == nt - 2);
            const char* a1 = cA + (size_t)(t + 1) * kstep;
            const char* a2 = last ? nA : cA + (size_t)(t + 2) * kstep; const char* b2 = last ? nB : cB + (size_t)(t + 2) * kstep;
            const char* a3 = a2 + kstep; const char* b3 = b2 + kstep;
            PG8_LDB(B0, 0, 0); PG8_SCHED; PG8_LDA(At, 0, 0); PG8_STAGE(PG8_SA(1, 1), a1 + hstepA, voffA);
            PG8_WAIT_L(8); PG8_BAR; PG8_WAIT_L(0); PG8_MMA(0, 0, At, B0); PG8_BAR; PG8_SCHED;
            PG8_LDB(B1, 0, 1); PG8_STAGE(PG8_SB(0, 0), b2, voffB);
            PG8_BAR; PG8_WAIT_L(0); PG8_MMA(0, 1, At, B1); PG8_BAR;
            PG8_LDA(At, 0, 1); PG8_STAGE(PG8_SA(0, 0), a2, voffA);
            PG8_BAR; PG8_WAIT_L(0); PG8_MMA(1, 0, At, B0); PG8_BAR; PG8_SCHED;
            PG8_STAGE(PG8_SB(0, 1), b2 + hstepB, voffB);
            PG8_WAIT_V(6); PG8_BAR; PG8_MMA(1, 1, At, B1); PG8_BAR;
            PG8_LDB(B0, 1, 0); PG8_SCHED; PG8_LDA(At, 1, 0); PG8_STAGE(PG8_SA(0, 1), a2 + hstepA, voffA);
            PG8_WAIT_L(8); PG8_BAR; PG8_WAIT_L(0); PG8_MMA(0, 0, At, B0); PG8_BAR; PG8_SCHED;
            PG8_LDB(B1, 1, 1); PG8_STAGE(PG8_SB(1, 0), b3, voffB);
            PG8_BAR; PG8_WAIT_L(0); PG8_MMA(0, 1, At, B1); PG8_BAR;
            PG8_LDA(At, 1, 1); PG8_STAGE(PG8_SA(1, 0), a3, voffA);
            PG8_BAR; PG8_WAIT_L(0); PG8_MMA(1, 0, At, B0); PG8_BAR; PG8_SCHED;
            PG8_STAGE(PG8_SB(1, 1), b3 + hstepB, voffB);
            PG8_WAIT_V(6); PG8_BAR; PG8_MMA(1, 1, At, B1); PG8_BAR;
        }
        E(acc, cur, wr, wc, fr, fq);
        if (!has_next) break;
#pragma unroll
        for (int a = 0; a < 2; ++a)
#pragma unroll
            for (int b = 0; b < 2; ++b)
#pragma unroll
                for (int m = 0; m < 4; ++m)
#pragma unroll
                    for (int n = 0; n < 2; ++n) acc[a][b][m][n] = (f32x4){0.f, 0.f, 0.f, 0.f};
        cur = nxt; cA = nA; cB = nB; ++ui;
    }
    PG8_WAIT_V(0);
    if (wr == 0) PG8_BAR;
    PG8_BAR;
#undef PG8_SA
#undef PG8_SB
#undef PG8_STAGE
#undef PG8_LDA
#undef PG8_LDB
#undef PG8_MMA
#undef PG8_WAIT_V
#undef PG8_WAIT_L
#undef PG8_BAR
#undef PG8_SCHED
}

struct EpiZ {
    static constexpr bool PERM = true;
    bf16_t* Z; const float* rowss;
    __device__ __forceinline__ void operator()(const f32x4 (&acc)[2][2][4][2], const Unit& u, int wr, int wc, int fr, int fq) const {
        const int row0 = u.pm * BM + wr * 64 + fr, col0 = u.pn * BM + wc * 32 + 8 * fq;
#pragma unroll
        for (int ai = 0; ai < 2; ++ai)
#pragma unroll
            for (int m = 0; m < 4; ++m) { const int row = row0 + ai * HALF + m * 16; const float rs = row_rs(rowss, row);
                GAS bf16_t* rowp = (GAS bf16_t*)Z + (size_t)row * NZ + col0;
#pragma unroll
                for (int bj = 0; bj < 2; ++bj) { const f32x4 v0 = acc[ai][bj][m][0] * rs, v1 = acc[ai][bj][m][1] * rs;
                    u32x4 w; w.x = pk2(v0[0], v0[1]); w.y = pk2(v0[2], v0[3]); w.z = pk2(v1[0], v1[1]); w.w = pk2(v1[2], v1[3]);
                    *(GAS u32x4*)(rowp + bj * HALF) = w; } }
    }
};
struct EpiAct {
    static constexpr bool PERM = true;
    bf16_t* O; const float* rowss;
    __device__ __forceinline__ void operator()(const f32x4 (&acc)[2][2][4][2], const Unit& u, int wr, int wc, int fr, int fq) const {
        const int row0 = u.pm * BM + wr * 64 + fr, col0 = u.pn * HALF + wc * 32 + 8 * fq;
#pragma unroll
        for (int ai = 0; ai < 2; ++ai)
#pragma unroll
            for (int m = 0; m < 4; ++m) { const int row = row0 + ai * HALF + m * 16; const float rs = row_rs(rowss, row);
                float o[8];
#pragma unroll
                for (int n = 0; n < 2; ++n)
#pragma unroll
                    for (int j = 0; j < 4; ++j) { const float gg = acc[ai][0][m][n][j] * rs, uu = acc[ai][1][m][n][j] * rs; o[n * 4 + j] = siluf(gg) * uu; }
                *(GAS u32x4*)((GAS bf16_t*)O + (size_t)row * FF + col0) = pack8(o); }
    }
};
struct EpiRes {
    static constexpr bool PERM = false;
    const float* xbase; const bf16_t* hbase; bf16_t* hout; float* rowss_next;
    __device__ __forceinline__ void operator()(const f32x4 (&acc)[2][2][4][2], const Unit& u, int wr, int wc, int fr, int fq) const {
        const int row0 = u.pm * BM + wr * 64 + fr, col0 = u.pn * BM + wc * 32 + 4 * fq;
#pragma unroll
        for (int ai = 0; ai < 2; ++ai)
#pragma unroll
            for (int m = 0; m < 4; ++m) { const int row = row0 + ai * HALF + m * 16; const size_t off = (size_t)row * DM + col0; float ss = 0.f;
#pragma unroll
                for (int bj = 0; bj < 2; ++bj)
#pragma unroll
                    for (int n = 0; n < 2; ++n) { f32x4 bs;
                        if (xbase) bs = __builtin_nontemporal_load((const GAS f32x4*)((const GAS float*)xbase + off + bj * HALF + n * 16));
                        else { const u32x2 hw = *(const GAS u32x2*)((const GAS bf16_t*)hbase + off + bj * HALF + n * 16); bs = (f32x4){bf_lo(hw.x), bf_hi(hw.x), bf_lo(hw.y), bf_hi(hw.y)}; }
                        const f32x4 o = bs + acc[ai][bj][m][n];
                        u32x2 w; w.x = pk2(o[0], o[1]); w.y = pk2(o[2], o[3]); *(GAS u32x2*)((GAS bf16_t*)hout + off + bj * HALF + n * 16) = w;
                        ss += (o[0] * o[0] + o[1] * o[1]) + (o[2] * o[2] + o[3] * o[3]); }
                ss += __shfl_xor(ss, 16); ss += __shfl_xor(ss, 32);
                if (fq == 0) row_ss_add(rowss_next, row, ss);
                asm volatile("" ::: "memory"); }
    }
};
struct EpiTmp {
    static constexpr bool PERM = false;
    bf16_t* C;
    __device__ __forceinline__ void operator()(const f32x4 (&acc)[2][2][4][2], const Unit& u, int wr, int wc, int fr, int fq) const {
        const int row0 = u.pm * BM + wr * 64 + fr, col0 = u.pn * BM + wc * 32 + 4 * fq;
#pragma unroll
        for (int ai = 0; ai < 2; ++ai)
#pragma unroll
            for (int m = 0; m < 4; ++m) { GAS bf16_t* rowp = (GAS bf16_t*)C + (size_t)(row0 + ai * HALF + m * 16) * DM + col0;
#pragma unroll
                for (int bj = 0; bj < 2; ++bj)
#pragma unroll
                    for (int n = 0; n < 2; ++n) { const f32x4 o = acc[ai][bj][m][n]; u32x2 w; w.x = pk2(o[0], o[1]); w.y = pk2(o[2], o[3]); *(GAS u32x2*)(rowp + bj * HALF + n * 16) = w; } }
    }
};
struct EpiPle {
    static constexpr bool PERM = false;
    const bf16_t* tmp; const bf16_t* hin; bf16_t* hout; const float* rowss; float* rowss_next; float* hout32;
    __device__ __forceinline__ void operator()(const f32x4 (&acc)[2][2][4][2], const Unit& u, int wr, int wc, int fr, int fq) const {
        const int row0 = u.pm * BM + wr * 64 + fr, col0 = u.pn * BM + wc * 32 + 4 * fq;
#pragma unroll
        for (int ai = 0; ai < 2; ++ai)
#pragma unroll
            for (int m = 0; m < 4; ++m) { const int row = row0 + ai * HALF + m * 16; const size_t off = (size_t)row * DM + col0; float ss = 0.f;
                const float rs = row_rs(rowss, row);
#pragma unroll
                for (int bj = 0; bj < 2; ++bj)
#pragma unroll
                    for (int n = 0; n < 2; ++n) { const u32x2 hw = *(const GAS u32x2*)((const GAS bf16_t*)hin + off + bj * HALF + n * 16); const u32x2 tw = *(const GAS u32x2*)((const GAS bf16_t*)tmp + off + bj * HALF + n * 16);
                        const f32x4 bs = {bf_lo(hw.x), bf_hi(hw.x), bf_lo(hw.y), bf_hi(hw.y)}; const f32x4 pr = {bf_lo(tw.x), bf_hi(tw.x), bf_lo(tw.y), bf_hi(tw.y)};
                        f32x4 o;
#pragma unroll
                        for (int j = 0; j < 4; ++j) o[j] = bs[j] + pr[j] * sigm(acc[ai][bj][m][n][j] * rs);
                        u32x2 w; w.x = pk2(o[0], o[1]); w.y = pk2(o[2], o[3]); if (hout32) *(GAS f32x4*)((GAS float*)hout32 + off + bj * HALF + n * 16) = o; else *(GAS u32x2*)((GAS bf16_t*)hout + off + bj * HALF + n * 16) = w;
                        ss += (o[0] * o[0] + o[1] * o[1]) + (o[2] * o[2] + o[3] * o[3]); }
                ss += __shfl_xor(ss, 16); ss += __shfl_xor(ss, 32);
                if (fq == 0) row_ss_add(rowss_next, row, ss);
                asm volatile("" ::: "memory"); }
    }
};
}

struct Ctx {
    typedef const float* const __attribute__((address_space(4)))* KAP;
    KAP ka; GAS unsigned char* ws; GAS float* outg; int layer; int G, bid;
    __device__ __forceinline__ const float* in(int i) const { return (const float*)(const GAS float*)ka[i]; }
    template <class T> __device__ __forceinline__ T* w(size_t off) const { return (T*)(GAS T*)(ws + off); }
    __device__ __forceinline__ float* out() const { return (float*)outg; }
    __device__ __forceinline__ void refresh() {
        KAP k = (KAP)__builtin_amdgcn_kernarg_segment_ptr(); asm volatile("" : "+s"(k)); ka = k;
        ws = (GAS unsigned char*)k[32]; outg = (GAS float*)k[31]; bid = lsg(blockIdx.x); G = lsg(gridDim.x); }
};

__device__ __forceinline__ int zsrc_col(int n) {
    if (n < 256) return 256 + n;
    if (n < 512) return 784 + (n - 256);
    if (n < 768) return 1552 + (n - 512);
    if (n < 1024) return 2576 + (n - 768);
    if (n < 1152) return n - 1024;
    if (n < 1280) return 128 + (n - 1152);
    if (n < 1536) return 528 + (n - 1280);
    if (n < 1792) return 1040 + (n - 1536);
    if (n < 2048) return 1296 + (n - 1792);
    if (n < 2304) return 1808 + (n - 2048);
    if (n < 2560) return 2064 + (n - 2304);
    if (n < 2816) return 2320 + (n - 2560);
    return 2840 + (n - 2816);
}
__device__ __forceinline__ void convT_tile(float* sm, const float* src, int pitch, int src_col0, int k0, const float* gain, bf16_t* dst, int dst_row0, int dstK, int tid) {
#pragma unroll
    for (int i = 0; i < 2; ++i) { const int kk = (tid >> 4) + 32 * i, c4 = (tid & 15) * 4;
        const f32x4 v = *(const f32x4*)(src + (size_t)(k0 + kk) * pitch + src_col0 + c4); const float g = gain ? gain[k0 + kk] : 1.f;
        float* d = sm + kk * 65 + c4; d[0] = v[0] * g; d[1] = v[1] * g; d[2] = v[2] * g; d[3] = v[3] * g; }
    __syncthreads();
    { const int n = tid >> 3, k8 = (tid & 7) * 8; float v[8];
#pragma unroll
      for (int j = 0; j < 8; ++j) v[j] = sm[(k8 + j) * 65 + n];
      *(u32x4*)(dst + (size_t)(dst_row0 + n) * dstK + k0 + k8) = pack8(v); }
    __syncthreads();
}
constexpr int CT_IN = 48 * 16, CT_OUT = 256, CT_GLU = 16, CT_EARLY = CT_IN + CT_OUT + CT_GLU, CT_ALL = CT_EARLY + 88 * 16 + 16 * 44 + 256 + 64;
static __device__ __forceinline__ void phase_conv(const Ctx& c, float* sm, const int l, const int wid, const int nw, const int t_lo, const int t_hi, const bool do_small) {
    const int tid = ltid();
    const float* w_in = c.in(I_WIN) + (size_t)l * DM * INW; const float* g_mix = c.in(I_NMIX) + l * DM;
    const float* w_out = c.in(I_WOUT) + (size_t)l * DM * DM;
    const float* w_up = c.in(I_WUP) + (size_t)l * DM * NUP; const float* g_ffn = c.in(I_NFFN) + l * DM;
    const float* w_dn = c.in(I_WDN) + (size_t)l * FF * DM;
    const float* w_pg = c.in(I_WPG) + (size_t)l * DM * DM; const float* g_ple = c.in(I_NPLE) + l * DM;
    const float* w_pp = c.in(I_WPP) + (size_t)l * PLED * DM;
    const float* w_glu = c.in(I_S5_WGLU) + (size_t)l * 256 * 256;
    constexpr int T_IN = 48 * 16, T_OUT = 256, T_UP = 88 * 16, T_DN = 16 * 44, T_PG = 256, T_PP = 64, T_GLU = 16;
    constexpr int T_ALL = T_IN + T_OUT + T_UP + T_DN + T_PG + T_PP + T_GLU;
    struct TD { const float* src; const float* gain; bf16_t* dst; int pitch, sc, k0, row0, dstK; };
    auto desc = [&](int t) -> TD {
        int u = t;
        if (u < T_IN) { const int nt = u >> 4, kt = u & 15; return TD{w_in, g_mix, c.w<bf16_t>(WS_WIN), INW, zsrc_col(nt * 64), kt * 64, nt * 64, DM}; }
        u -= T_IN;
        if (u < T_OUT) { const int nt = u >> 4, kt = u & 15; return TD{w_out, nullptr, c.w<bf16_t>(WS_WOUT), DM, nt * 64, kt * 64, nt * 64, DM}; }
        u -= T_OUT;
        if (u < T_GLU) { const int nt = u >> 2, kt = u & 3; return TD{w_glu, nullptr, c.w<bf16_t>(WS_WGLU), 256, nt * 64, kt * 64, nt * 64, 256}; }
        u -= T_GLU;
        if (u < T_UP) { const int nt = u >> 4, kt = u & 15; const int n0 = nt * 64, pn = n0 >> 8, r = n0 & 255; const int sc = (r < 128) ? (128 * pn + r) : (FF + 128 * pn + (r - 128));
            return TD{w_up, g_ffn, c.w<bf16_t>(WS_WUP), NUP, sc, kt * 64, n0, DM}; }
        u -= T_UP;
        if (u < T_DN) { const int nt = u / 44, kt = u % 44; return TD{w_dn, nullptr, c.w<bf16_t>(WS_WDN), DM, nt * 64, kt * 64, nt * 64, FF}; }
        u -= T_DN;
        if (u < T_PG) { const int nt = u >> 4, kt = u & 15; return TD{w_pg, g_ple, c.w<bf16_t>(WS_WPG), DM, nt * 64, kt * 64, nt * 64, DM}; }
        u -= T_PG;
        { const int nt = u >> 2, kt = u & 3; return TD{w_pp, nullptr, c.w<bf16_t>(WS_WPP), DM, nt * 64, kt * 64, nt * 64, PLED}; }
    };
    static_assert(T_ALL == CT_ALL && T_IN + T_OUT + T_GLU == CT_EARLY, "tile ranges");
    for (int t0 = t_lo + wid; t0 < t_hi; t0 += 4 * nw) {
        f32x4 v[4][2];
#pragma unroll
        for (int u = 0; u < 4; ++u) { const int t = t0 + u * nw;
            if (t < t_hi) { const TD d = desc(t);
#pragma unroll
                for (int i = 0; i < 2; ++i) { const int kk = (tid >> 4) + 32 * i, c4 = (tid & 15) * 4;
                    const f32x4 x = __builtin_nontemporal_load((const f32x4*)(d.src + (size_t)(d.k0 + kk) * d.pitch + d.sc + c4)); const float g = d.gain ? d.gain[d.k0 + kk] : 1.f; v[u][i] = x * g; } }
            else { v[u][0] = (f32x4){0.f, 0.f, 0.f, 0.f}; v[u][1] = v[u][0]; } }
#pragma unroll
        for (int u = 0; u < 4; ++u)
#pragma unroll
            for (int i = 0; i < 2; ++i) { const int kk = (tid >> 4) + 32 * i, c4 = (tid & 15) * 4; float* dd = sm + u * 4160 + kk * 65 + c4; dd[0] = v[u][i][0]; dd[1] = v[u][i][1]; dd[2] = v[u][i][2]; dd[3] = v[u][i][3]; }
        __syncthreads();
#pragma unroll
        for (int u = 0; u < 4; ++u) { const int t = t0 + u * nw;
            if (t < t_hi) { const TD d = desc(t); const int n = tid >> 3, k8 = (tid & 7) * 8; float w[8];
#pragma unroll
                for (int j = 0; j < 8; ++j) w[j] = sm[u * 4160 + (k8 + j) * 65 + n];
                *(u32x4*)(d.dst + (size_t)(d.row0 + n) * d.dstK + d.k0 + k8) = pack8(w); } }
        __syncthreads();
    }
    if (!do_small) return;
    const int gtid = wid * NTHR + tid, gsz = nw * NTHR;
    { bf16_t* ws_sm = c.w<bf16_t>(WS_WSM);
      for (int e = gtid; e < 32 * DM; e += gsz) { const int j = e >> 10, k = e & 1023; float v = 0.f;
          if (j < 24) { const int col = (j < 16) ? (512 + j) : (j < 20 ? 2832 + (j - 16) : 2836 + (j - 20)); v = g_mix[k] * w_in[(size_t)k * INW + col]; }
          ws_sm[e] = (bf16_t)f2bf(v); } }
    for (int e = gtid; e < 16 * 8 * 64; e += gsz) {
        const int g = e >> 9, ct = (e >> 6) & 7, ln = e & 63; const int n = ln & 15, q = ln >> 4; const int pp = 16 * ct + n; const int p = pp & 63; const bool im = pp >= 64; const int gp = g * 64 + p;
        const float lre = fminf(c.in(I_S5_LRE)[l * 1024 + gp], -1e-4f), lim = c.in(I_S5_LIM)[l * 1024 + gp];
        const float dt = __expf(c.in(I_S5_LOGDT)[l * 16 + g]);
        const double x = (double)lre * (double)dt, y = (double)lim * (double)dt;
        float s1, c1; sincos_d(y, s1, c1);
        const float m1 = __expf((float)x);
        const float ar = m1 * c1, ai = m1 * s1;
        if (ct < 4 && q == 0) { float s64, c64; sincos_d(64.0 * y, s64, c64); const float m64 = __expf((float)(64.0 * x));
            float* A = c.w<float>(WS_S5A); A[gp] = ar; A[1024 + gp] = ai; A[2048 + gp] = m64 * c64; A[3072 + gp] = m64 * s64; }
        const float nr = ar - 1.f, ni = ai, den = 1.f / (lre * lre + lim * lim);
        const float cr = (nr * lre + ni * lim) * den, ci = (ni * lre - nr * lim) * den;
        const float* bre = c.in(I_S5_BRE) + (size_t)l * 16384 + (size_t)gp * 16 + 8 * (q & 1); const float* bim = c.in(I_S5_BIM) + (size_t)l * 16384 + (size_t)gp * 16 + 8 * (q & 1);
        float v[8];
#pragma unroll
        for (int j = 0; j < 8; ++j) { const float br = bre[j], bi = bim[j]; const float val = im ? (cr * bi + ci * br) : (cr * br - ci * bi);
            const float hi = __builtin_bit_cast(float, f2bf(val) << 16); v[j] = (q < 2) ? hi : (val - hi); }
        *(u32x4*)(c.w<bf16_t>(WS_S5BB) + (size_t)e * 8) = pack8(v);
    }
    if (l == 0) {
        float* rowss = c.w<float>(WS_ROWSS); bf16_t* hb = c.w<bf16_t>(WS_HB); const float* x = c.in(I_X);
        for (int e = gtid; e < 6 * MTOK; e += gsz) ((u64_t*)rowss)[MTOK + e] = 0u;
        const int lane = tid & 63, gw = wid * 8 + (tid >> 6), nwv = nw * 8;
        for (int row = gw; row < MTOK; row += nwv) { float ss = 0.f;
#pragma unroll
            for (int i = 0; i < 4; ++i) { const f32x4 v = __builtin_nontemporal_load((const f32x4*)(x + (size_t)row * DM + i * 256 + lane * 4)); ss += (v[0] * v[0] + v[1] * v[1]) + (v[2] * v[2] + v[3] * v[3]);
                u32x2 w; w.x = pk2(v[0], v[1]); w.y = pk2(v[2], v[3]); *(u32x2*)(hb + (size_t)row * DM + i * 256 + lane * 4) = w; }
#pragma unroll
            for (int o = 32; o > 0; o >>= 1) ss += __shfl_xor(ss, o);
            if (lane == 0) ((u64_t*)rowss)[row] = (u64_t)(ss * SS_SCALE + 0.5f); }
    }
}

static __device__ __forceinline__ void small_proj(const Ctx& c, const bf16_t* hb, const float* rowss) {
    const int tid = ltid(), lane = tid & 63, i = lane & 15, q = lane >> 4;
    const bf16_t* wsm = c.w<bf16_t>(WS_WSM); float* zs = c.w<float>(WS_ZS);
    for (int wt = c.bid * 8 + (tid >> 6); wt < MTOK / 16; wt += c.G * 8) {
        const bf16_t* ap = hb + (size_t)(wt * 16 + i) * DM + 8 * q; const bf16_t* b0 = wsm + (size_t)i * DM + 8 * q; const bf16_t* b1 = wsm + (size_t)(16 + i) * DM + 8 * q;
        f32x4 a0 = {0.f, 0.f, 0.f, 0.f}, a1 = {0.f, 0.f, 0.f, 0.f};
#pragma unroll 8
        for (int k = 0; k < DM; k += 32) { const bf16x8 av = *(const bf16x8*)(ap + k), bv0 = *(const bf16x8*)(b0 + k), bv1 = *(const bf16x8*)(b1 + k);
            a0 = __builtin_amdgcn_mfma_f32_16x16x32_bf16(av, bv0, a0, 0, 0, 0); a1 = __builtin_amdgcn_mfma_f32_16x16x32_bf16(av, bv1, a1, 0, 0, 0); }
#pragma unroll
        for (int r = 0; r < 4; ++r) { const int row = wt * 16 + 4 * q + r; const float rs = row_rs(rowss, row);
            zs[(size_t)row * 32 + i] = a0[r] * rs; zs[(size_t)row * 32 + 16 + i] = a1[r] * rs; }
    }
}

static __device__ __forceinline__ void gdn_m1(const Ctx& c, float* sm, int item) {
    const int tid = ltid(), lane = tid & 63, wv = tid >> 6, l = c.layer;
    const int n = item & 31, h = (item >> 5) & 3, b = item >> 7; const int tok0 = b * SEQL + n * 64;
    float* Q = sm; float* Kk = sm + 4352; float* V = sm + 8704; float* AM = sm + 13056; float* QK = sm + 17408; float* X = sm + 21760; float* beta = sm + 30208; float* gc = beta + 64;
    const bf16_t* z = c.w<bf16_t>(WS_Z); const float* zs = c.w<float>(WS_ZS);
    if (tid < 64) {
        const float* zr = zs + (size_t)(tok0 + tid) * 32; const float db = zr[16 + h], da = zr[20 + h];
        float g = -__expf(c.in(I_GDN_ALOG)[l * 4 + h]) * softplusf(da + c.in(I_GDN_DTB)[l * 4 + h]);
#pragma unroll
        for (int o = 1; o < 64; o <<= 1) { const float t = __shfl_up(g, o); if (lane >= o) g += t; }
        beta[tid] = sigm(db); gc[tid] = g;
    }
    {
        float* RAW = AM;
        u32x4 rw[4];
#pragma unroll
        for (int i = 0; i < 4; ++i) { const int idx = tid + i * NTHR; rw[i] = (u32x4){0u, 0u, 0u, 0u};
            if (idx < 3 * 536) { const int part = idx / 536, rem = idx - part * 536; const int rr = rem >> 3, c8 = (rem & 7) * 8;
                const int zcol = (part == 0 ? ZC_DQ : (part == 1 ? ZC_DK : ZC_DV)) + h * 64;
                if (!(n == 0 && rr < 3)) rw[i] = *(const u32x4*)(z + (size_t)(tok0 - 3 + rr) * NZ + zcol + c8); } }
        const int r = tid >> 3, c8 = (tid & 7) * 8;
        f32x4 cwv[3][4][2];
#pragma unroll
        for (int part = 0; part < 3; ++part) { const float* cw = c.in(I_GDN_CONV) + (size_t)l * 4 * 768 + part * 256 + h * 64 + c8;
#pragma unroll
            for (int t = 0; t < 4; ++t) { cwv[part][t][0] = *(const f32x4*)(cw + t * 768); cwv[part][t][1] = *(const f32x4*)(cw + t * 768 + 4); } }
#pragma unroll
        for (int i = 0; i < 4; ++i) { const int idx = tid + i * NTHR;
            if (idx < 3 * 536) { const int part = idx / 536, rem = idx - part * 536; const int rr = rem >> 3, cc = (rem & 7) * 8; float v[8]; unpack8(rw[i], v);
                float* d = RAW + part * 4560 + rr * 68 + cc; *(f32x4*)d = (f32x4){v[0], v[1], v[2], v[3]}; *(f32x4*)(d + 4) = (f32x4){v[4], v[5], v[6], v[7]}; } }
        LBAR();
        f32x4 o[3][2];
#pragma unroll
        for (int part = 0; part < 3; ++part) { f32x4 a0 = {0.f, 0.f, 0.f, 0.f}, a1 = {0.f, 0.f, 0.f, 0.f};
#pragma unroll
            for (int t = 0; t < 4; ++t) { const float* raw = RAW + part * 4560 + (r + t) * 68 + c8; a0 += cwv[part][t][0] * *(const f32x4*)raw; a1 += cwv[part][t][1] * *(const f32x4*)(raw + 4); }
#pragma unroll
            for (int j = 0; j < 4; ++j) { a0[j] = siluf(a0[j]); a1[j] = siluf(a1[j]); }
            o[part][0] = a0; o[part][1] = a1; }
#pragma unroll
        for (int part = 0; part < 3; ++part) { float* dst = (part == 0 ? Q : (part == 1 ? Kk : V)) + r * 68 + c8; *(f32x4*)dst = o[part][0]; *(f32x4*)(dst + 4) = o[part][1]; }
        LBAR();
    }
    { const int r = tid >> 3, c8 = (tid & 7) * 8;
#pragma unroll
      for (int mt = 0; mt < 2; ++mt) { float* p = (mt ? Kk : Q) + r * 68 + c8; const f32x4 u0 = *(const f32x4*)p, u1 = *(const f32x4*)(p + 4);
          float ss = ((u0[0] * u0[0] + u0[1] * u0[1]) + (u0[2] * u0[2] + u0[3] * u0[3])) + ((u1[0] * u1[0] + u1[1] * u1[1]) + (u1[2] * u1[2] + u1[3] * u1[3]));
          ss += __shfl_xor(ss, 1); ss += __shfl_xor(ss, 2); ss += __shfl_xor(ss, 4);
          const float sc = rsqrtf(ss + EPSF) * (mt ? 1.f : 0.125f);
          *(f32x4*)p = u0 * sc; *(f32x4*)(p + 4) = u1 * sc; } }
    LBAR();
    for (int job = wv; job < 20; job += 8) {
        const int which = job >= 10, p = job - which * 10; const int ti = (p >= 6) ? 3 : ((p >= 3) ? 2 : ((p >= 1) ? 1 : 0)), tj = p - ti * (ti + 1) / 2; float* dstm = which ? QK : AM;
        f32x4 acc = {0.f, 0.f, 0.f, 0.f};
        acc = mm16v<true>((which ? Q : Kk) + ti * 16 * 68, 68, Kk + tj * 16 * 68, 68, 64, acc, lane);
#pragma unroll
        for (int r = 0; r < 4; ++r) { const int i = ti * 16 + 4 * (lane >> 4) + r, j = tj * 16 + (lane & 15);
            const float dec = (i >= j) ? __expf(gc[i] - gc[j]) : 0.f;
            float v = acc[r] * dec; if (!which) v = (i > j) ? v * beta[i] : 0.f;
            dstm[i * 68 + j] = v; }
    }
    for (int e = tid; e < 1024; e += NTHR) { const int i = e >> 4, j = (e & 15) * 4; if ((j >> 4) > (i >> 4)) *(f32x4*)(QK + i * 68 + j) = (f32x4){0.f, 0.f, 0.f, 0.f}; }
    for (int e = tid; e < 64 * 32; e += NTHR) { const int i = e >> 5, c4 = (e & 31) * 4; const float bi = beta[i];
        const f32x4 src = (c4 < 64) ? *(const f32x4*)(V + i * 68 + c4) : *(const f32x4*)(Kk + i * 68 + c4 - 64); const float f = (c4 < 64) ? bi : bi * __expf(gc[i]);
        *(f32x4*)(X + i * 132 + c4) = src * f; }
    LBAR();
    if (wv < 4) {
        const int I = wv, li = lane & 15, lq = lane >> 4; const float* Nm = AM + (I * 16) * 68 + I * 16;
        float* INV = V + I * 272; float* T0 = V + 1088 + wv * 816; float* T1 = T0 + 272; float* T2 = T1 + 272; const f32x4 zero4 = {0.f, 0.f, 0.f, 0.f};
#define WR_T(T, v) do { _Pragma("unroll") for (int r = 0; r < 4; ++r) (T)[(4 * lq + r) * 17 + li] = (v)[r]; } while (0)
#define WFENCE() asm volatile("s_waitcnt lgkmcnt(0)" ::: "memory")
        f32x4 p1;
#pragma unroll
        for (int r = 0; r < 4; ++r) p1[r] = ((4 * lq + r) == li ? 1.f : 0.f) - Nm[(4 * lq + r) * 68 + li];
        const f32x4 n2 = mm16(Nm, 68, 1, Nm, 68, 1, 16, zero4, lane);
        WR_T(T0, n2); WR_T(T1, p1); WFENCE();
        const f32x4 p2 = mm16(T1, 17, 1, T0, 17, 1, 16, p1, lane);
        const f32x4 n4 = mm16(T0, 17, 1, T0, 17, 1, 16, zero4, lane);
        WFENCE(); WR_T(T1, p2); WR_T(T2, n4); WFENCE();
        const f32x4 p3 = mm16(T1, 17, 1, T2, 17, 1, 16, p2, lane);
        const f32x4 n8 = mm16(T2, 17, 1, T2, 17, 1, 16, zero4, lane);
        WFENCE(); WR_T(T1, p3); WR_T(T0, n8); WFENCE();
        const f32x4 p4 = mm16(T1, 17, 1, T0, 17, 1, 16, p3, lane);
        WR_T(INV, p4);
    }
    LBAR();
    { const int li = lane & 15, lq = lane >> 4;
#pragma unroll 1
      for (int I = 0; I < 4; ++I) { float* Xt = X + (I * 16) * 132 + wv * 16;
          if (I > 0) { f32x4 acc = {0.f, 0.f, 0.f, 0.f}; acc = mm16v<false>(AM + I * 16 * 68, 68, X + wv * 16, 132, 16 * I, acc, lane);
#pragma unroll
              for (int r = 0; r < 4; ++r) Xt[(4 * lq + r) * 132 + li] -= acc[r];
              WFENCE(); }
          f32x4 xs = {0.f, 0.f, 0.f, 0.f}; xs = mm16(V + I * 272, 17, 1, Xt, 132, 1, 16, xs, lane);
          WFENCE();
#pragma unroll
          for (int r = 0; r < 4; ++r) Xt[(4 * lq + r) * 132 + li] = xs[r];
          WFENCE(); } }
#undef WR_T
#undef WFENCE
    LBAR();
    { const int r = tid >> 3, c8 = (tid & 7) * 8; const size_t o = (size_t)item * 4096 + r * 64 + c8;
      float* U = c.w<float>(WS_GU) + o; float* W = c.w<float>(WS_GW) + o; float* A = c.w<float>(WS_GA) + o;
      *(f32x4*)U = *(const f32x4*)(X + r * 132 + c8); *(f32x4*)(U + 4) = *(const f32x4*)(X + r * 132 + c8 + 4);
      *(f32x4*)W = *(const f32x4*)(X + r * 132 + 64 + c8); *(f32x4*)(W + 4) = *(const f32x4*)(X + r * 132 + 64 + c8 + 4);
      *(f32x4*)A = *(const f32x4*)(QK + r * 68 + c8); *(f32x4*)(A + 4) = *(const f32x4*)(QK + r * 68 + c8 + 4);
      const float eg = __expf(gc[r]); float qd[8], ke[8];
#pragma unroll
      for (int j = 0; j < 8; ++j) { qd[j] = ((j < 4) ? (*(const f32x4*)(Q + r * 68 + c8))[j & 3] : (*(const f32x4*)(Q + r * 68 + c8 + 4))[j & 3]) * eg; ke[j] = Kk[(c8 + j) * 68 + r] * __expf(gc[63] - gc[c8 + j]); }
      *(u32x4*)(c.w<bf16_t>(WS_GQD) + o) = pack8(qd); *(u32x4*)(c.w<bf16_t>(WS_GKE) + o) = pack8(ke);
      if (tid == 0) c.w<float>(WS_GDL)[item] = __expf(gc[63]); }
    LBAR();
}

static __device__ __forceinline__ void gdn_m2(const Ctx& c, float* sm, int item) {
    const int tid = ltid(), lane = tid & 63, wv = tid >> 6;
    const int sl = item & 3, bh = item >> 2;
    float* S = sm; float* VN = sm + 1152;
    for (int e = tid; e < 1152; e += NTHR) S[e] = 0.f;
    const int ti = wv & 3, i = lane & 15, q = lane >> 4, row = ti * 16 + i;
    const float* GDL = c.w<float>(WS_GDL) + bh * 32;
    LBAR();
    if (wv < 4) {
        struct PA { f32x4 w[4]; u32x4 k[2]; float u[4]; float dl; };
        PA P0, P1, P2, P3;
        const float* Wb = c.w<float>(WS_GW) + (size_t)bh * 32 * 4096 + row * 64 + 16 * q;
        const bf16_t* Kb = c.w<bf16_t>(WS_GKE) + (size_t)bh * 32 * 4096 + row * 64 + 16 * q;
        const float* Ub = c.w<float>(WS_GU) + (size_t)bh * 32 * 4096 + (ti * 16 + 4 * q) * 64 + sl * 16 + i;
#define LOAD_A(P, nn) do { const int n_ = ((nn) < NCH) ? (nn) : NCH - 1; const float* Wp = Wb + (size_t)n_ * 4096; const bf16_t* Kp = Kb + (size_t)n_ * 4096; const float* Up = Ub + (size_t)n_ * 4096; \
        P.w[0] = *(const f32x4*)Wp; P.w[1] = *(const f32x4*)(Wp + 4); P.w[2] = *(const f32x4*)(Wp + 8); P.w[3] = *(const f32x4*)(Wp + 12); \
        P.k[0] = *(const u32x4*)Kp; P.k[1] = *(const u32x4*)(Kp + 8); P.u[0] = Up[0]; P.u[1] = Up[64]; P.u[2] = Up[128]; P.u[3] = Up[192]; P.dl = GDL[n_]; } while (0)
#define STEP_A(P, PN, n) do { LOAD_A(PN, (n) + 3); \
        f32x4 a0 = {0.f, 0.f, 0.f, 0.f}, a1 = {0.f, 0.f, 0.f, 0.f}; \
        { const f32x4 s0_ = *(const f32x4*)(S + i * 68 + 16 * q), s1_ = *(const f32x4*)(S + i * 68 + 16 * q + 4), s2_ = *(const f32x4*)(S + i * 68 + 16 * q + 8), s3_ = *(const f32x4*)(S + i * 68 + 16 * q + 12); \
        _Pragma("unroll") for (int e = 0; e < 4; ++e) { a0 = __builtin_amdgcn_mfma_f32_16x16x4f32(P.w[0][e], s0_[e], a0, 0, 0, 0); a1 = __builtin_amdgcn_mfma_f32_16x16x4f32(P.w[2][e], s2_[e], a1, 0, 0, 0); } \
        _Pragma("unroll") for (int e = 0; e < 4; ++e) { a0 = __builtin_amdgcn_mfma_f32_16x16x4f32(P.w[1][e], s1_[e], a0, 0, 0, 0); a1 = __builtin_amdgcn_mfma_f32_16x16x4f32(P.w[3][e], s3_[e], a1, 0, 0, 0); } } \
        a0 += a1; \
        { f32x4 vn_; _Pragma("unroll") for (int r = 0; r < 4; ++r) vn_[r] = P.u[r] - a0[r]; *(f32x4*)(VN + i * 68 + ti * 16 + 4 * q) = vn_; } \
        LBAR(); \
        float kt[16]; unpack8(P.k[0], kt); unpack8(P.k[1], kt + 8); \
        f32x4 b0 = {0.f, 0.f, 0.f, 0.f}, b1 = {0.f, 0.f, 0.f, 0.f}; \
        { const f32x4 v0_ = *(const f32x4*)(VN + i * 68 + 16 * q), v1_ = *(const f32x4*)(VN + i * 68 + 16 * q + 4), v2_ = *(const f32x4*)(VN + i * 68 + 16 * q + 8), v3_ = *(const f32x4*)(VN + i * 68 + 16 * q + 12); \
        _Pragma("unroll") for (int e = 0; e < 4; ++e) { b0 = __builtin_amdgcn_mfma_f32_16x16x4f32(kt[e], v0_[e], b0, 0, 0, 0); b1 = __builtin_amdgcn_mfma_f32_16x16x4f32(kt[8 + e], v2_[e], b1, 0, 0, 0); } \
        _Pragma("unroll") for (int e = 0; e < 4; ++e) { b0 = __builtin_amdgcn_mfma_f32_16x16x4f32(kt[4 + e], v1_[e], b0, 0, 0, 0); b1 = __builtin_amdgcn_mfma_f32_16x16x4f32(kt[12 + e], v3_[e], b1, 0, 0, 0); } } \
        b0 += b1; \
        { float* sp_ = S + i * 68 + ti * 16 + 4 * q; const f32x4 so_ = *(const f32x4*)sp_; *(f32x4*)sp_ = so_ * P.dl + b0; } \
        LBAR(); } while (0)
        LOAD_A(P0, 0); LOAD_A(P1, 1); LOAD_A(P2, 2);
#pragma unroll 1
        for (int n = 0; n < NCH; n += 4) { STEP_A(P0, P3, n); STEP_A(P1, P0, n + 1); STEP_A(P2, P1, n + 2); STEP_A(P3, P2, n + 3); }
#undef STEP_A
#undef LOAD_A
    } else {
        struct PB { u32x4 qd[2]; f32x4 a[4]; };
        PB P0, P1, P2, P3;
        const bf16_t* Qb = c.w<bf16_t>(WS_GQD) + (size_t)bh * 32 * 4096 + row * 64 + 16 * q;
        const float* Ab = c.w<float>(WS_GA) + (size_t)bh * 32 * 4096 + row * 64 + 16 * q;
        float* Ob = c.w<float>(WS_GU) + (size_t)bh * 32 * 4096 + (ti * 16 + 4 * q) * 64 + sl * 16 + i;
#define LOAD_B(P, nn) do { const int n_ = ((nn) < NCH) ? (nn) : NCH - 1; const bf16_t* Qp = Qb + (size_t)n_ * 4096; const float* Ap = Ab + (size_t)n_ * 4096; \
        P.qd[0] = *(const u32x4*)Qp; P.qd[1] = *(const u32x4*)(Qp + 8); P.a[0] = *(const f32x4*)Ap; P.a[1] = *(const f32x4*)(Ap + 4); P.a[2] = *(const f32x4*)(Ap + 8); P.a[3] = *(const f32x4*)(Ap + 12); } while (0)
#define STEP_B(P, PN, n) do { LOAD_B(PN, (n) + 3); \
        float qt[16]; unpack8(P.qd[0], qt); unpack8(P.qd[1], qt + 8); \
        f32x4 a0 = {0.f, 0.f, 0.f, 0.f}, a1 = {0.f, 0.f, 0.f, 0.f}; \
        { const f32x4 s0_ = *(const f32x4*)(S + i * 68 + 16 * q), s1_ = *(const f32x4*)(S + i * 68 + 16 * q + 4), s2_ = *(const f32x4*)(S + i * 68 + 16 * q + 8), s3_ = *(const f32x4*)(S + i * 68 + 16 * q + 12); \
        _Pragma("unroll") for (int e = 0; e < 4; ++e) { a0 = __builtin_amdgcn_mfma_f32_16x16x4f32(qt[e], s0_[e], a0, 0, 0, 0); a1 = __builtin_amdgcn_mfma_f32_16x16x4f32(qt[8 + e], s2_[e], a1, 0, 0, 0); } \
        _Pragma("unroll") for (int e = 0; e < 4; ++e) { a0 = __builtin_amdgcn_mfma_f32_16x16x4f32(qt[4 + e], s1_[e], a0, 0, 0, 0); a1 = __builtin_amdgcn_mfma_f32_16x16x4f32(qt[12 + e], s3_[e], a1, 0, 0, 0); } } \
        LBAR(); \
        { const f32x4 v0_ = *(const f32x4*)(VN + i * 68 + 16 * q), v1_ = *(const f32x4*)(VN + i * 68 + 16 * q + 4), v2_ = *(const f32x4*)(VN + i * 68 + 16 * q + 8), v3_ = *(const f32x4*)(VN + i * 68 + 16 * q + 12); \
        _Pragma("unroll") for (int e = 0; e < 4; ++e) { a0 = __builtin_amdgcn_mfma_f32_16x16x4f32(P.a[0][e], v0_[e], a0, 0, 0, 0); a1 = __builtin_amdgcn_mfma_f32_16x16x4f32(P.a[2][e], v2_[e], a1, 0, 0, 0); } \
        _Pragma("unroll") for (int e = 0; e < 4; ++e) { a0 = __builtin_amdgcn_mfma_f32_16x16x4f32(P.a[1][e], v1_[e], a0, 0, 0, 0); a1 = __builtin_amdgcn_mfma_f32_16x16x4f32(P.a[3][e], v3_[e], a1, 0, 0, 0); } } \
        a0 += a1; \
        { float* Op = Ob + (size_t)(n) * 4096; Op[0] = a0[0]; Op[64] = a0[1]; Op[128] = a0[2]; Op[192] = a0[3]; } \
        LBAR(); } while (0)
        LOAD_B(P0, 0); LOAD_B(P1, 1); LOAD_B(P2, 2);
#pragma unroll 1
        for (int n = 0; n < NCH; n += 4) { STEP_B(P0, P3, n); STEP_B(P1, P0, n + 1); STEP_B(P2, P1, n + 2); STEP_B(P3, P2, n + 3); }
#undef STEP_B
#undef LOAD_B
    }
}
static __device__ __forceinline__ void gdn_m3(const Ctx& c, int item) {
    const int tid = ltid(), l = c.layer; const int n = item & 31, h = (item >> 5) & 3, b = item >> 7; const int tok0 = b * SEQL + n * 64;
    const int r = tid >> 3, c8 = (tid & 7) * 8;
    const float* O = c.w<float>(WS_GU) + (size_t)item * 4096 + r * 64 + c8; bf16_t* z = c.w<bf16_t>(WS_Z) + (size_t)(tok0 + r) * NZ;
    const f32x4 a = *(const f32x4*)O, bq = *(const f32x4*)(O + 4); float v[8] = {a[0], a[1], a[2], a[3], bq[0], bq[1], bq[2], bq[3]};
    float ss = 0.f;
#pragma unroll
    for (int j = 0; j < 8; ++j) ss += v[j] * v[j];
    ss += __shfl_xor(ss, 1); ss += __shfl_xor(ss, 2); ss += __shfl_xor(ss, 4);
    const float rs = rsqrtf(ss * (1.f / 64.f) + EPSF); float gt[8]; unpack8(*(const u32x4*)(z + ZC_DG + h * 64 + c8), gt);
    const float* ng = c.in(I_GDN_NORM) + l * 64 + c8;
#pragma unroll
    for (int j = 0; j < 8; ++j) v[j] = v[j] * rs * ng[j] * siluf(gt[j]);
    *(u32x4*)(z + ZC_DV + h * 64 + c8) = pack8(v);
}

__device__ __forceinline__ float ret_loggamma(int h) { const float x = __builtin_bit_cast(float, (unsigned)(127 - 5 - h) << 23); return -x * (1.f + x * (0.5f + x * (0.33333334f + x * (0.25f + x * 0.2f)))); }
__device__ __forceinline__ void rope_tab(const Ctx& c, float* cs, float* sn, int tok0, int tid) {
    const int* pos = (const int*)c.in(I_POS);
    { const int s = tid >> 3, j4 = (tid & 7) * 4; const float pf = (float)pos[tok0 + s]; f32x4 cv, sv;
#pragma unroll
      for (int e = 0; e < 4; ++e) { const float invf = exp2f(-13.287712379549449f * (float)(j4 + e) * (1.f / 31.f)); float s1, c1; sincos_d((double)(pf * invf), s1, c1); cv[e] = c1; sv[e] = s1; }
      *(f32x4*)(cs + s * 32 + j4) = cv; *(f32x4*)(sn + s * 32 + j4) = sv; }
}
__device__ __forceinline__ void rope_apply(float* Mx, const float* cs, const float* sn, int tid, const float* rowscale  , float gs) {
    { const int s = tid >> 3, j4 = (tid & 7) * 4; const f32x4 x1 = *(const f32x4*)(Mx + s * 68 + j4), x2 = *(const f32x4*)(Mx + s * 68 + 32 + j4), cv = *(const f32x4*)(cs + s * 32 + j4), sv = *(const f32x4*)(sn + s * 32 + j4);
      const float f = gs * (rowscale ? rowscale[s] : 1.f);
      *(f32x4*)(Mx + s * 68 + j4) = (x1 * cv - x2 * sv) * f; *(f32x4*)(Mx + s * 68 + 32 + j4) = (x1 * sv + x2 * cv) * f; }
}
static __device__ __forceinline__ void ret_m1(const Ctx& c, float* sm, int item) {
    const int tid = ltid(), lane = tid & 63, wv = tid >> 6; const int n = item & 31, h = (item >> 5) & 3, b = item >> 7; const int tok0 = b * SEQL + n * 64;
    float* Kk = sm; float* V = sm + 4352; float* cs = sm + 8704; float* sn = cs + 2048; float* zeta = sn + 2048;
    const bf16_t* z = c.w<bf16_t>(WS_Z) + (size_t)tok0 * NZ;
    { const u32x4 rk = ldg_tile64(z + ZC_RK + h * 64, NZ, tid), rv = ldg_tile64(z + ZC_RV + h * 64, NZ, tid); st_tile64(Kk, rk, tid); st_tile64(V, rv, tid); }
    rope_tab(c, cs, sn, tok0, tid);
    const float lg = ret_loggamma(h);
    if (tid < 64) zeta[tid] = __expf((63.f - (float)tid) * lg);
    LBAR();
    rope_apply(Kk, cs, sn, tid, zeta, 0.125f);
    LBAR();
    float* DS = c.w<float>(WS_RDS) + (size_t)item * 4096;
    { const int ti = wv >> 1, cb = 32 * (wv & 1); f32x4 a0 = {0.f, 0.f, 0.f, 0.f}, a1 = a0;
      mm16t2(Kk + ti * 16, 68, V + cb, 68, 64, a0, a1, lane);
      float* dp = DS + (cb + 2 * (lane & 15)) * 64 + ti * 16 + 4 * (lane >> 4); *(f32x4*)dp = a0; *(f32x4*)(dp + 64) = a1; }
    LBAR();
}
static __device__ __forceinline__ void ret_m3(const Ctx& c, float* sm, int item) {
    const int tid = ltid(), lane = tid & 63, wv = tid >> 6, l = c.layer; const int n = item & 31, h = (item >> 5) & 3, b = item >> 7; const int tok0 = b * SEQL + n * 64;
    float* Q = sm; float* Kk = sm + 4352; float* V = sm + 8704; float* S = sm + 13056; float* Pm = sm + 17408; float* O = sm + 21760; float* cs = sm + 26112; float* sn = cs + 2048;
    bf16_t* z = c.w<bf16_t>(WS_Z) + (size_t)tok0 * NZ;
    { const u32x4 rq = ldg_tile64(z + ZC_RQ + h * 64, NZ, tid), rk = ldg_tile64(z + ZC_RK + h * 64, NZ, tid), rv = ldg_tile64(z + ZC_RV + h * 64, NZ, tid);
      const float* Sg = c.w<float>(WS_RDS) + (size_t)item * 4096 + (tid >> 3) * 64 + (tid & 7) * 8; const f32x4 s0 = *(const f32x4*)Sg, s1 = *(const f32x4*)(Sg + 4);
      st_tile64(Q, rq, tid); st_tile64(Kk, rk, tid); st_tile64(V, rv, tid); *(f32x4*)(S + (tid >> 3) * 68 + (tid & 7) * 8) = s0; *(f32x4*)(S + (tid >> 3) * 68 + (tid & 7) * 8 + 4) = s1; }
    rope_tab(c, cs, sn, tok0, tid);
    const float lg = ret_loggamma(h);
    LBAR();
    rope_apply(Q, cs, sn, tid, nullptr, 1.f); rope_apply(Kk, cs, sn, tid, nullptr, 0.125f);
    LBAR();
    { const int ti = wv >> 1, cb = 32 * (wv & 1), li = lane & 15, lq = lane >> 4;
      f32x4 p0 = {0.f, 0.f, 0.f, 0.f}, p1 = p0;
      if (cb <= ti * 16 + 15) mm16v2<true>(Q + ti * 16 * 68, 68, Kk + cb * 68, 68, 64, p0, p1, lane);
#pragma unroll
      for (int r = 0; r < 4; ++r) { const int i = ti * 16 + 4 * lq + r, j = cb + 2 * li; f32x2 pv;
          pv[0] = (i >= j) ? p0[r] * __expf((float)(i - j) * lg) : 0.f; pv[1] = (i >= j + 1) ? p1[r] * __expf((float)(i - j - 1) * lg) : 0.f;
          *(f32x2*)(Pm + i * 68 + j) = pv; }
      LBAR();
      f32x4 a0 = {0.f, 0.f, 0.f, 0.f}, a1 = a0, c0 = a0, c1 = a0;
      mm16v2<false>(Pm + ti * 16 * 68, 68, V + cb, 68, 16 * (ti + 1), a0, a1, lane);
      mm16v2<true>(Q + ti * 16 * 68, 68, S + cb * 68, 68, 64, c0, c1, lane);
#pragma unroll
      for (int r = 0; r < 4; ++r) { const int i = ti * 16 + 4 * lq + r, j = cb + 2 * li; const float xi = __expf((float)(i + 1) * lg);
          *(f32x2*)(O + i * 68 + j) = (f32x2){a0[r] + xi * c0[r], a1[r] + xi * c1[r]}; } }
    LBAR();
    { const int r = tid >> 3, c8 = (tid & 7) * 8; float v[8]; float s1 = 0.f;
#pragma unroll
      for (int j = 0; j < 8; ++j) { v[j] = ((j < 4) ? (*(const f32x4*)(O + r * 68 + c8))[j & 3] : (*(const f32x4*)(O + r * 68 + c8 + 4))[j & 3]); s1 += v[j]; }
      s1 += __shfl_xor(s1, 1); s1 += __shfl_xor(s1, 2); s1 += __shfl_xor(s1, 4);
      const float mean = s1 * (1.f / 64.f); float s2 = 0.f;
#pragma unroll
      for (int j = 0; j < 8; ++j) { v[j] -= mean; s2 += v[j] * v[j]; }
      s2 += __shfl_xor(s2, 1); s2 += __shfl_xor(s2, 2); s2 += __shfl_xor(s2, 4);
      const float rs = rsqrtf(s2 * (1.f / 64.f) + EPSF); float gt[8]; unpack8(*(const u32x4*)(z + (size_t)r * NZ + ZC_RG + h * 64 + c8), gt);
      const float* ng = c.in(I_RET_NORM) + l * 256 + h * 64 + c8;
#pragma unroll
      for (int j = 0; j < 8; ++j) v[j] = v[j] * rs * ng[j] * siluf(gt[j]);
      *(u32x4*)(z + (size_t)r * NZ + ZC_RV + h * 64 + c8) = pack8(v); }
    LBAR();
}

__device__ __forceinline__ void gla_gates(const Ctx& c, float* Gb, float* AL, float* Wa, float* ba, int tok0, int h, int tid) {
    const int l = c.layer; const float* zs = c.w<float>(WS_ZS);
    { const float a0 = zs[(size_t)(tok0 + (tid >> 4)) * 32 + (tid & 15)], a1 = zs[(size_t)(tok0 + 32 + (tid >> 4)) * 32 + (tid & 15)];
      const float w0 = c.in(I_GLA_WA2)[(size_t)l * 16 * 128 + (tid >> 5) * 128 + h * 32 + (tid & 31)]; const float b0 = c.in(I_GLA_BA)[l * 128 + h * 32 + (tid & 31)];
      AL[tid] = a0; AL[512 + tid] = a1; Wa[tid] = w0; if (tid < 32) ba[tid] = b0; }
    LBAR();
    { const int s = tid >> 3, d4 = (tid & 7) * 4; f32x4 a = *(const f32x4*)(ba + d4);
#pragma unroll
      for (int r4 = 0; r4 < 4; ++r4) { const f32x4 al = *(const f32x4*)(AL + s * 16 + 4 * r4);
#pragma unroll
          for (int e = 0; e < 4; ++e) a += *(const f32x4*)(Wa + (4 * r4 + e) * 32 + d4) * al[e]; }
#pragma unroll
      for (int j = 0; j < 4; ++j) Gb[s * 33 + d4 + j] = -softplusf(-a[j]) * (1.f / 16.f); }
    LBAR();
    { const int wv = tid >> 6, lane = tid & 63;
#pragma unroll
      for (int j = 0; j < 4; ++j) { const int d = wv * 4 + j; float v = Gb[lane * 33 + d];
#pragma unroll
          for (int o = 1; o < 64; o <<= 1) { const float t = __shfl_up(v, o); if (lane >= o) v += t; }
          Gb[lane * 33 + d] = v; } }
    LBAR();
}
__device__ __forceinline__ void ld_tile64x32(float* dst  , const bf16_t* src, int tid) {
    if (tid < 256) { const int r = tid >> 2, c8 = (tid & 3) * 8; float v[8]; unpack8(*(const u32x4*)(src + (size_t)r * NZ + c8), v);
        float* d = dst + r * 36 + c8; *(f32x4*)d = (f32x4){v[0], v[1], v[2], v[3]}; *(f32x4*)(d + 4) = (f32x4){v[4], v[5], v[6], v[7]}; }
}
static __device__ __forceinline__ void gla_m1(const Ctx& c, float* sm, int item) {
    const int tid = ltid(), lane = tid & 63, wv = tid >> 6; const int n = item & 31, h = (item >> 5) & 3, b = item >> 7; const int tok0 = b * SEQL + n * 64;
    float* Kk = sm; float* V = sm + 2304; float* Gb = sm + 6656; float* AL = sm + 8768; float* Wa = AL + 1024; float* ba = Wa + 512;
    const bf16_t* z = c.w<bf16_t>(WS_Z) + (size_t)tok0 * NZ;
    { const u32x4 rk = ldg_tile64x32(z + ZC_AK + h * 32, tid), rv = ldg_tile64(z + ZC_AV + h * 64, NZ, tid); st_tile64x32(Kk, rk, tid); st_tile64(V, rv, tid); }
    gla_gates(c, Gb, AL, Wa, ba, tok0, h, tid);
    { const int s = tid >> 3, d4 = (tid & 7) * 4; f32x4 kv = *(const f32x4*)(Kk + s * 36 + d4);
#pragma unroll
      for (int j = 0; j < 4; ++j) kv[j] *= __expf(Gb[63 * 33 + d4 + j] - Gb[s * 33 + d4 + j]);
      *(f32x4*)(Kk + s * 36 + d4) = kv; }
    LBAR();
    { const int ti = wv >> 2, tj = wv & 3; f32x4 acc = {0.f, 0.f, 0.f, 0.f};
      acc = mm16(Kk + ti * 16, 1, 36, V + tj * 16, 68, 1, 64, acc, lane);
      float* DS = c.w<float>(WS_ADS) + (size_t)item * 2048;
      *(f32x4*)(DS + (tj * 16 + (lane & 15)) * 32 + ti * 16 + 4 * (lane >> 4)) = acc; }
    if (tid < 32) c.w<float>(WS_GLDEC)[item * 32 + tid] = __expf(Gb[63 * 33 + tid]);
    LBAR();
}
static __device__ __forceinline__ void gla_m3(const Ctx& c, float* sm, int item) {
    const int tid = ltid(), lane = tid & 63, wv = tid >> 6, l = c.layer; const int n = item & 31, h = (item >> 5) & 3, b = item >> 7; const int tok0 = b * SEQL + n * 64;
    float* Q = sm; float* Kk = sm + 2304; float* V = sm + 4608; float* S = sm + 8960  ; float* Pm = sm + 11264; float* O = sm + 15616; float* Gb = sm + 19968; float* AL = sm + 22080; float* Wa = AL + 1024; float* ba = Wa + 512;
    bf16_t* z = c.w<bf16_t>(WS_Z) + (size_t)tok0 * NZ;
    { const u32x4 rq = ldg_tile64x32(z + ZC_AQ + h * 32, tid), rk = ldg_tile64x32(z + ZC_AK + h * 32, tid), rv = ldg_tile64(z + ZC_AV + h * 64, NZ, tid);
      const float* Sg = c.w<float>(WS_ADS) + (size_t)item * 2048; const int r = tid >> 3, c4 = (tid & 7) * 4; const f32x4 s0 = *(const f32x4*)(Sg + r * 32 + c4);
      st_tile64x32(Q, rq, tid); st_tile64x32(Kk, rk, tid); st_tile64(V, rv, tid); *(f32x4*)(S + r * 36 + c4) = s0; }
    gla_gates(c, Gb, AL, Wa, ba, tok0, h, tid);
    { const int s = tid >> 3, d4 = (tid & 7) * 4; f32x4 qv = *(const f32x4*)(Q + s * 36 + d4), kv = *(const f32x4*)(Kk + s * 36 + d4);
#pragma unroll
      for (int j = 0; j < 4; ++j) { const float bb = Gb[s * 33 + d4 + j]; qv[j] *= __expf(bb) * 0.17677669529663687f; kv[j] *= __expf(-bb); }
      *(f32x4*)(Q + s * 36 + d4) = qv; *(f32x4*)(Kk + s * 36 + d4) = kv; }
    LBAR();
    { const int ti = wv >> 1, cb = 32 * (wv & 1), li = lane & 15, lq = lane >> 4;
      f32x4 p0 = {0.f, 0.f, 0.f, 0.f}, p1 = p0;
      if (cb <= ti * 16 + 15) mm16v2<true>(Q + ti * 16 * 36, 36, Kk + cb * 36, 36, 32, p0, p1, lane);
#pragma unroll
      for (int r = 0; r < 4; ++r) { const int i = ti * 16 + 4 * lq + r, j = cb + 2 * li;
          *(f32x2*)(Pm + i * 68 + j) = (f32x2){(i >= j) ? p0[r] : 0.f, (i >= j + 1) ? p1[r] : 0.f}; }
      LBAR();
      f32x4 a0 = {0.f, 0.f, 0.f, 0.f}, a1 = a0;
      mm16v2<false>(Pm + ti * 16 * 68, 68, V + cb, 68, 16 * (ti + 1), a0, a1, lane);
      mm16v2<true>(Q + ti * 16 * 36, 36, S + cb * 36, 36, 32, a0, a1, lane);
#pragma unroll
      for (int r = 0; r < 4; ++r) { const int i = ti * 16 + 4 * lq + r, j = cb + 2 * li; *(f32x2*)(O + i * 68 + j) = (f32x2){a0[r], a1[r]}; } }
    LBAR();
    { const int r = tid >> 3, c8 = (tid & 7) * 8; float v[8]; float ss = 0.f;
#pragma unroll
      for (int j = 0; j < 8; ++j) { v[j] = ((j < 4) ? (*(const f32x4*)(O + r * 68 + c8))[j & 3] : (*(const f32x4*)(O + r * 68 + c8 + 4))[j & 3]); ss += v[j] * v[j]; }
      ss += __shfl_xor(ss, 1); ss += __shfl_xor(ss, 2); ss += __shfl_xor(ss, 4);
      const float rs = rsqrtf(ss * (1.f / 64.f) + EPSF); float gt[8]; unpack8(*(const u32x4*)(z + (size_t)r * NZ + ZC_AR + h * 64 + c8), gt);
      const float* ng = c.in(I_GLA_NORM) + l * 64 + c8;
#pragma unroll
      for (int j = 0; j < 8; ++j) v[j] = v[j] * rs * ng[j] * siluf(gt[j]);
      *(u32x4*)(z + (size_t)r * NZ + ZC_AV + h * 64 + c8) = pack8(v); }
    LBAR();
}

template <bool OUT>
static __device__ __forceinline__ void s5_item(const Ctx& c, unsigned char* smb, int item) {
    const int tid = ltid(), lane = tid & 63, wv = tid >> 6, l = c.layer; const int b = item >> 5, n = item & 31; const int tok0 = b * SEQL + n * 64;
    bf16_t* UY = (bf16_t*)smb;
    float* ST = (float*)(smb + 33792) + wv * 2112;
    bf16_t* z = c.w<bf16_t>(WS_Z) + (size_t)tok0 * NZ;
    { u32x4 ru[4];
#pragma unroll
      for (int i = 0; i < 4; ++i) { const int e = tid + i * NTHR; ru[i] = *(const u32x4*)(z + (size_t)(e >> 5) * NZ + ZC_SU + (e & 31) * 8); }
#pragma unroll
      for (int i = 0; i < 4; ++i) { const int e = tid + i * NTHR; *(u32x4*)(UY + (e >> 5) * 264 + (e & 31) * 8) = ru[i]; } }
    LBAR();
    const float* A = c.w<float>(WS_S5A); const int hh = lane & 15, q = lane >> 4;
    for (int gi = 0; gi < 2; ++gi) {
        const int g = wv + 8 * gi, gp = g * 64 + lane;
        const float ar = A[gp], ai = A[1024 + gp];
        bf16x8 BF[8];
        { const bf16_t* BB = c.w<bf16_t>(WS_S5BB) + ((size_t)(g * 8) * 64 + lane) * 8;
#pragma unroll
          for (int ct = 0; ct < 8; ++ct) BF[ct] = *(const bf16x8*)(BB + (size_t)ct * 512); }
        f32x2* Ep = (f32x2*)c.w<float>(WS_S5E) + ((size_t)((b * 16 + g) * 32 + n)) * 64 + lane;
        float xr = 0.f, xi = 0.f;
        float C2[32]; float dsk = 0.f;
        if (OUT) { const f32x2 s0 = *Ep; xr = s0[0]; xi = s0[1];
            const float* cre = c.in(I_S5_CRE) + (size_t)l * 16384 + (size_t)(g * 16 + hh) * 64; const float* cim = c.in(I_S5_CIM) + (size_t)l * 16384 + (size_t)(g * 16 + hh) * 64;
#pragma unroll
            for (int i4 = 0; i4 < 8; ++i4) {
                const f32x4 cv = (q < 2) ? *(const f32x4*)(cre + 32 * q + 4 * i4) : *(const f32x4*)(cim + 32 * (q - 2) + 4 * i4); const float sg = (q < 2) ? 1.f : -1.f;
                C2[4 * i4] = sg * cv[0]; C2[4 * i4 + 1] = sg * cv[1]; C2[4 * i4 + 2] = sg * cv[2]; C2[4 * i4 + 3] = sg * cv[3]; }
            dsk = c.in(I_S5_D)[l * 256 + g * 16 + hh]; }
        for (int sub = 0; sub < 4; ++sub) {
            { const bf16x8 af = *(const bf16x8*)(UY + (sub * 16 + hh) * 264 + g * 16 + 8 * (q & 1));
#pragma unroll
              for (int ct = 0; ct < 8; ++ct) { f32x4 bu = {0.f, 0.f, 0.f, 0.f}; bu = __builtin_amdgcn_mfma_f32_16x16x32_bf16(af, BF[ct], bu, 0, 0, 0);
#pragma unroll
                  for (int r = 0; r < 4; ++r) ST[(4 * q + r) * 132 + ct * 16 + hh] = bu[r]; } }
            asm volatile("s_waitcnt lgkmcnt(0)" ::: "memory");
#pragma unroll 4
            for (int s = 0; s < 16; ++s) { const float bur = ST[s * 132 + lane], bui = ST[s * 132 + 64 + lane];
                const float nr = ar * xr - ai * xi + bur, ni = ar * xi + ai * xr + bui; xr = nr; xi = ni;
                if (OUT) { ST[s * 132 + lane] = xr; ST[s * 132 + 64 + lane] = xi; } }
            if (OUT) {
                asm volatile("s_waitcnt lgkmcnt(0)" ::: "memory");
                f32x4 acc = {0.f, 0.f, 0.f, 0.f}, acc2 = {0.f, 0.f, 0.f, 0.f};
#pragma unroll
                for (int i4 = 0; i4 < 8; ++i4) { const f32x4 sv = *(const f32x4*)(ST + hh * 132 + 32 * q + 4 * i4);
                    if (i4 & 1) { acc2 = __builtin_amdgcn_mfma_f32_16x16x4f32(sv[0], C2[4 * i4], acc2, 0, 0, 0); acc2 = __builtin_amdgcn_mfma_f32_16x16x4f32(sv[1], C2[4 * i4 + 1], acc2, 0, 0, 0);
                                  acc2 = __builtin_amdgcn_mfma_f32_16x16x4f32(sv[2], C2[4 * i4 + 2], acc2, 0, 0, 0); acc2 = __builtin_amdgcn_mfma_f32_16x16x4f32(sv[3], C2[4 * i4 + 3], acc2, 0, 0, 0); }
                    else        { acc = __builtin_amdgcn_mfma_f32_16x16x4f32(sv[0], C2[4 * i4], acc, 0, 0, 0); acc = __builtin_amdgcn_mfma_f32_16x16x4f32(sv[1], C2[4 * i4 + 1], acc, 0, 0, 0);
                                  acc = __builtin_amdgcn_mfma_f32_16x16x4f32(sv[2], C2[4 * i4 + 2], acc, 0, 0, 0); acc = __builtin_amdgcn_mfma_f32_16x16x4f32(sv[3], C2[4 * i4 + 3], acc, 0, 0, 0); } }
                acc += acc2;
#pragma unroll
                for (int r = 0; r < 4; ++r) { const int t = sub * 16 + 4 * q + r; bf16_t* p = UY + t * 264 + g * 16 + hh; const float y = acc[r] + dsk * bf2f(*p); *p = (bf16_t)f2bf(gelu_tanh(y)); }
            }
            asm volatile("s_waitcnt lgkmcnt(0)" ::: "memory");
        }
        if (!OUT) *Ep = (f32x2){xr, xi};
    }
    if (OUT) {
        LBAR();
        const bf16_t* Wg = c.w<bf16_t>(WS_WGLU); f32x4 acc[4][2];
#pragma unroll
        for (int a = 0; a < 4; ++a) { acc[a][0] = (f32x4){0.f, 0.f, 0.f, 0.f}; acc[a][1] = (f32x4){0.f, 0.f, 0.f, 0.f}; }
#pragma unroll 2
        for (int k = 0; k < 256; k += 32) {
            const bf16x8 b0 = *(const bf16x8*)(Wg + (size_t)(wv * 32 + hh) * 256 + k + 8 * q), b1 = *(const bf16x8*)(Wg + (size_t)(wv * 32 + 16 + hh) * 256 + k + 8 * q);
#pragma unroll
            for (int a = 0; a < 4; ++a) { const bf16x8 av = *(const bf16x8*)(UY + (a * 16 + hh) * 264 + k + 8 * q);
                acc[a][0] = __builtin_amdgcn_mfma_f32_16x16x32_bf16(av, b0, acc[a][0], 0, 0, 0); acc[a][1] = __builtin_amdgcn_mfma_f32_16x16x32_bf16(av, b1, acc[a][1], 0, 0, 0); }
        }
        const float* bg = c.in(I_S5_BGLU) + l * 256;
#pragma unroll
        for (int a = 0; a < 4; ++a)
#pragma unroll
            for (int jn = 0; jn < 2; ++jn) { const int col = wv * 32 + jn * 16 + hh; const float bb = bg[col];
#pragma unroll
                for (int r = 0; r < 4; ++r) { const int row = a * 16 + 4 * q + r; const float y = bf2f(UY[row * 264 + col]);
                    z[(size_t)row * NZ + ZC_SU + col] = (bf16_t)f2bf(y * sigm(acc[a][jn][r] + bb)); } }
    }
    LBAR();
}

static __device__ __forceinline__ void scan_tasks(const Ctx& c, int wid, int nworkers) {
    const int gt = wid * NTHR + ltid(), gs = nworkers * NTHR;
    constexpr int T_RET = 32 * 1024, T_GLA = 32 * 512, T_S5 = 8192;
    for (int t = gt; t < T_RET + T_GLA + T_S5; t += gs) {
        if (t < T_RET) { const int bh = t >> 10, e4 = (t & 1023) * 4; const int h = bh & 3; const float a = __expf(64.f * ret_loggamma(h));
            float* p = c.w<float>(WS_RDS) + (size_t)bh * 32 * 4096 + e4; f32x4 S = {0.f, 0.f, 0.f, 0.f}; asm volatile("" : "+v"(S));
#pragma unroll 1
            for (int hf = 0; hf < 8; ++hf) { f32x4 inc[4];
#pragma unroll
                for (int n = 0; n < 4; ++n) inc[n] = *(const f32x4*)(p + (size_t)(hf * 4 + n) * 4096);
#pragma unroll
                for (int n = 0; n < 4; ++n) { *(f32x4*)(p + (size_t)(hf * 4 + n) * 4096) = S; S = S * a + inc[n]; } } }
        else if (t < T_RET + T_GLA) { const int u = t - T_RET; const int bh = u >> 9, e4 = (u & 511) * 4; const int dk = e4 & 31;
            float* p = c.w<float>(WS_ADS) + (size_t)bh * 32 * 2048 + e4; const float* dec = c.w<float>(WS_GLDEC) + (size_t)bh * 32 * 32 + dk; f32x4 S = {0.f, 0.f, 0.f, 0.f}; asm volatile("" : "+v"(S));
#pragma unroll 1
            for (int hf = 0; hf < 8; ++hf) { f32x4 inc[4]; f32x4 av[4];
#pragma unroll
                for (int n = 0; n < 4; ++n) { inc[n] = *(const f32x4*)(p + (size_t)(hf * 4 + n) * 2048); av[n] = *(const f32x4*)(dec + (hf * 4 + n) * 32); }
#pragma unroll
                for (int n = 0; n < 4; ++n) { *(f32x4*)(p + (size_t)(hf * 4 + n) * 2048) = S; S = S * av[n] + inc[n]; } } }
        else { const int u = t - T_RET - T_GLA; const int bg = u >> 6, pp = u & 63; const int g = bg & 15; const float* A = c.w<float>(WS_S5A); const float ar = A[2048 + g * 64 + pp], ai = A[3072 + g * 64 + pp];
            f32x2* p = (f32x2*)c.w<float>(WS_S5E) + (size_t)bg * 32 * 64 + pp; float xr = 0.f, xi = 0.f; asm volatile("" : "+v"(xr), "+v"(xi));
#pragma unroll 1
            for (int hf = 0; hf < 8; ++hf) { f32x2 ev[4];
#pragma unroll
                for (int n = 0; n < 4; ++n) ev[n] = p[(size_t)(hf * 4 + n) * 64];
#pragma unroll
                for (int n = 0; n < 4; ++n) { p[(size_t)(hf * 4 + n) * 64] = (f32x2){xr, xi}; const float nr = ar * xr - ai * xi + ev[n][0], ni = ar * xi + ai * xr + ev[n][1]; xr = nr; xi = ni; } } }
    }
}

static __device__ __forceinline__ void phase_m1(const Ctx& c, unsigned char* smb) {
    float* sm = (float*)smb;
    for (int it = c.bid; it < 1024 + 256; it += c.G) {
        if (it < 1024) gdn_m1(c, sm, it);
        else s5_item<false>(c, smb, it - 1024);
    }
}
static __device__ __forceinline__ void phase_m2(const Ctx& c, unsigned char* smb) {
    const int nA = c.G / 2; float* sm = (float*)smb;
    if (c.bid < nA) { for (int it = c.bid; it < 128; it += nA) { gdn_m2(c, sm, it); LBAR(); } }
    else { for (int it = c.bid - nA; it < 2048; it += c.G - nA) { if (it < 1024) ret_m1(c, sm, it); else gla_m1(c, sm, it - 1024); } }
}
static __device__ __forceinline__ void phase_m2b(const Ctx& c) { scan_tasks(c, c.bid, c.G); for (int it = c.bid; it < 1024; it += c.G) gdn_m3(c, it); }
static __device__ __forceinline__ void phase_m3(const Ctx& c, unsigned char* smb) {
    float* sm = (float*)smb;
    for (int it = c.bid; it < 256 + 2048; it += c.G) {
        if (it < 256) s5_item<true>(c, smb, it);
        else if (it < 1280) ret_m3(c, sm, it - 256);
        else if (it < 2304) gla_m3(c, sm, it - 1280);
    }
}
static __device__ __forceinline__ void phase_pb(const Ctx& c, const int wid, const int nw) {
    const float* p = c.in(I_P) + (size_t)c.layer * MTOK * PLED; bf16_t* pb = c.w<bf16_t>(WS_PB);
    const int tid = ltid();
    for (size_t e = (size_t)(wid * NTHR + tid) * 8; e < (size_t)MTOK * PLED; e += (size_t)nw * NTHR * 8) {
        const f32x4 a = __builtin_nontemporal_load((const f32x4*)(p + e)), b = __builtin_nontemporal_load((const f32x4*)(p + e + 4)); float v[8] = {a[0], a[1], a[2], a[3], b[0], b[1], b[2], b[3]}; *(u32x4*)(pb + e) = pack8(v); }
}
static __device__ __forceinline__ void phase_final(const Ctx& c) {
    const int tid = ltid(), lane = tid & 63; const float* rowss = c.w<float>(WS_ROWSS) + (size_t)6 * MTOK; const float* g = c.in(I_NFINAL); float* out = c.out();
    for (int row = c.bid * 8 + (tid >> 6); row < MTOK; row += c.G * 8) { const float rs = row_rs(rowss, row);
#pragma unroll
        for (int i = 0; i < 4; ++i) { float* p = out + (size_t)row * DM + i * 256 + lane * 4; const f32x4 v = __builtin_nontemporal_load((const f32x4*)p), gg = *(const f32x4*)(g + i * 256 + lane * 4); __builtin_nontemporal_store(v * rs * gg, (f32x4*)p); } }
}

#define XB_TMO      128
#define XB_XCNT(j)  (256  + 64 * (j))
#define XB_XSUB(j)  (1280 + 64 * (j))
#define XB_XGEN(j)  (2304 + 64 * (j))
#define XB_TOP      3328
#define XB_TOPGEN   3392
#define XCD_BAR_WORDS 3456
#define XB_SPIN_CAP (1u << 18)
__device__ __forceinline__ unsigned xb_ld(unsigned* p)              { return __hip_atomic_load(p, __ATOMIC_RELAXED, __HIP_MEMORY_SCOPE_AGENT); }
__device__ __forceinline__ unsigned xb_add(unsigned* p, unsigned v) { return __hip_atomic_fetch_add(p, v, __ATOMIC_RELAXED, __HIP_MEMORY_SCOPE_AGENT); }
__device__ __forceinline__ unsigned xb_xcc_id() { return (unsigned)__builtin_amdgcn_s_getreg((3 << 11) | 20) & 0xFu; }
#define XB_SPIN(cond, bar) do { unsigned _sp = 0; while (cond) { __builtin_amdgcn_s_sleep(1); \
    if ((++_sp & 255u) == 0u) { if (xb_ld(&(bar)[XB_TMO])) break; if (_sp > XB_SPIN_CAP) { atomicAdd(&(bar)[XB_TMO], 1u); break; } } } } while (0)
struct XcdBarrier { unsigned* bar; unsigned x; volatile LAS unsigned* st; };
__device__ __forceinline__ XcdBarrier xcd_barrier_post(unsigned* bar, volatile LAS unsigned* st) {
    XcdBarrier b; b.bar = bar; b.x = xb_xcc_id(); b.st = st;
    if (threadIdx.x == 0) (void)xb_add(&bar[XB_XCNT(b.x)], 1u);
    return b;
}
__device__ __forceinline__ void xcd_barrier_complete(unsigned* bar, unsigned x, unsigned& nloc, unsigned& nx) {
    const unsigned G = gridDim.x * gridDim.y * gridDim.z;
    unsigned sum, cnt, mine, sp = 0u;
    for (;;) {
        sum = 0u; cnt = 0u; mine = 0u;
#pragma unroll
        for (unsigned j = 0; j < 16; ++j) { const unsigned c = xb_ld(&bar[XB_XCNT(j)]); sum += c; cnt += (c > 0u) ? 1u : 0u; mine = (j == x) ? c : mine; }
        if (sum == G) break;
        __builtin_amdgcn_s_sleep(1);
        if ((++sp & 255u) == 0u) { if (xb_ld(&bar[XB_TMO])) break; if (sp > XB_SPIN_CAP) { atomicAdd(&bar[XB_TMO], 1u); break; } }
    }
    nloc = mine > 0u ? mine : 1u; nx = cnt > 0u ? cnt : 1u;
}
__device__ __forceinline__ void xcd_barrier(const XcdBarrier& b) {
    asm volatile("s_waitcnt vmcnt(0)" ::: "memory");
    __syncthreads();
    if (threadIdx.x == 0) {
        unsigned* bar = b.bar;
        __builtin_amdgcn_s_waitcnt(0);
        unsigned nloc = b.st[0], nx = b.st[1];
        if (nloc == 0u) { xcd_barrier_complete(bar, b.x, nloc, nx); b.st[0] = nloc; b.st[1] = nx; }
        const unsigned old = xb_add(&bar[XB_XSUB(b.x)], 1u);
        const unsigned gen = old / nloc;
        if (old + 1u == (gen + 1u) * nloc) {
            __builtin_amdgcn_fence(__ATOMIC_RELEASE, "agent");
            asm volatile("s_waitcnt vmcnt(0)" ::: "memory");
            const unsigned og = xb_add(&bar[XB_TOP], 1u);
            const unsigned tg = og / nx;
            if (og + 1u == (tg + 1u) * nx) xb_add(&bar[XB_TOPGEN], 1u);
            else XB_SPIN(xb_ld(&bar[XB_TOPGEN]) == tg, bar);
            __builtin_amdgcn_fence(__ATOMIC_ACQUIRE, "agent");
            xb_add(&bar[XB_XGEN(b.x)], 1u);
            asm volatile("s_waitcnt vmcnt(0)" ::: "memory");
        } else {
            XB_SPIN(xb_ld(&bar[XB_XGEN(b.x)]) == gen, bar);
            __builtin_amdgcn_fence(__ATOMIC_ACQUIRE, "agent");
            asm volatile("s_waitcnt vmcnt(0)" ::: "memory");
        }
    }
    __syncthreads();
}

__global__ void __launch_bounds__(NTHR) mega_fwd(Params P) {
    extern __shared__ __attribute__((aligned(16))) unsigned char lds_raw[];
    cg::grid_group grid = cg::this_grid();
    LAS unsigned char* lds = (LAS unsigned char*)lds_raw;
    Ctx c; c.refresh(); c.layer = 0;
    volatile LAS unsigned* bst = (volatile LAS unsigned*)(lds + LDS_BYTES - 16);
    if (threadIdx.x == 0) { bst[0] = 0u; bst[1] = 0u; }
    __syncthreads();
    (void)xcd_barrier_post((unsigned*)(c.ws + WS_BAR), bst);
    bool first_sync = true;
#define GSYNC() do { if (first_sync) { grid.sync(); first_sync = false; } else { c.refresh(); XcdBarrier xb_; xb_.bar = (unsigned*)(c.ws + WS_BAR); xb_.x = xb_xcc_id(); xb_.st = bst; xcd_barrier(xb_); } c.refresh(); } while (0)
    { constexpr int l = 0; c.layer = l;
        if (l == 0) phase_conv(c, (float*)lds_raw, 0, c.bid, c.G, 0, CT_ALL, true); else phase_conv(c, (float*)lds_raw, 1, c.bid, c.G, CT_EARLY, CT_ALL, false);
        GSYNC();
        { const bf16_t* hin = (l == 0) ? c.w<bf16_t>(WS_HB) : (const bf16_t*)c.out(); pg8::Gemm g{hin, c.w<bf16_t>(WS_WIN), MTOK, NZ, DM, DM}; pg8::StaticOrder S; S.init(MTOK, NZ, c.G, c.bid);
          pg8::EpiZ E{c.w<bf16_t>(WS_Z), c.w<float>(WS_ROWSS) + (size_t)(3 * l) * MTOK};
          pg8::gemm_phase<pg8::EpiZ>(lds, g, S, E);
          small_proj(c, (l == 0) ? c.w<bf16_t>(WS_HB) : (const bf16_t*)c.out(), c.w<float>(WS_ROWSS) + (size_t)(3 * l) * MTOK); }
        GSYNC();
        phase_m1(c, lds_raw);
        GSYNC();
        phase_m2(c, lds_raw);
        GSYNC();
        phase_m2b(c);
        GSYNC();
        phase_m3(c, lds_raw);
        GSYNC();
        { pg8::Gemm g{c.w<bf16_t>(WS_Z), c.w<bf16_t>(WS_WOUT), MTOK, DM, DM, NZ}; pg8::StaticOrder S; S.init(MTOK, DM, c.G, c.bid);
          pg8::EpiRes E{l == 0 ? c.in(I_X) : (const float*)nullptr, (const bf16_t*)c.out(), c.w<bf16_t>(WS_HB), c.w<float>(WS_ROWSS) + (size_t)(3 * l + 1) * MTOK};
          pg8::gemm_phase<pg8::EpiRes>(lds, g, S, E); }
        GSYNC();
        { pg8::Gemm g{c.w<bf16_t>(WS_HB), c.w<bf16_t>(WS_WUP), MTOK, NUP, DM, DM}; pg8::StaticOrder S; S.init(MTOK, NUP, c.G, c.bid);
          pg8::EpiAct E{c.w<bf16_t>(WS_ACT), c.w<float>(WS_ROWSS) + (size_t)(3 * l + 1) * MTOK};
          pg8::gemm_phase<pg8::EpiAct>(lds, g, S, E);
          { const int hG = c.G / 2; if (c.bid >= hG) { phase_pb(c, c.bid - hG, c.G - hG); if (l == 0) phase_conv(c, (float*)lds_raw, 1, c.bid - hG, c.G - hG, 0, CT_EARLY, true); } } }
        GSYNC();
        { pg8::Gemm g{c.w<bf16_t>(WS_ACT), c.w<bf16_t>(WS_WDN), MTOK, DM, FF, FF}; pg8::StaticOrder S; S.init(MTOK, DM, c.G, c.bid);
          pg8::EpiRes E{(const float*)nullptr, c.w<bf16_t>(WS_HB), c.w<bf16_t>(WS_HB), c.w<float>(WS_ROWSS) + (size_t)(3 * l + 2) * MTOK};
          pg8::gemm_phase<pg8::EpiRes>(lds, g, S, E);
        }
        GSYNC();
        { pg8::StaticOrder S; S.init(MTOK, DM, c.G, c.bid);
          pg8::Gemm g1{c.w<bf16_t>(WS_PB), c.w<bf16_t>(WS_WPP), MTOK, DM, PLED, PLED};
          pg8::EpiTmp E1{c.w<bf16_t>(WS_TMP)};
          pg8::gemm_phase<pg8::EpiTmp>(lds, g1, S, E1);
          pg8::Gemm g2{c.w<bf16_t>(WS_HB), c.w<bf16_t>(WS_WPG), MTOK, DM, DM, DM};
          pg8::EpiPle E2{c.w<bf16_t>(WS_TMP), c.w<bf16_t>(WS_HB), (l == 0) ? (bf16_t*)c.out() : c.w<bf16_t>(WS_HB2), c.w<float>(WS_ROWSS) + (size_t)(3 * l + 2) * MTOK, c.w<float>(WS_ROWSS) + (size_t)(3 * l + 3) * MTOK, (l == 0) ? (float*)nullptr : c.out()};
          pg8::gemm_phase<pg8::EpiPle>(lds, g2, S, E2); }
        GSYNC();
        }
    { constexpr int l = 1; c.layer = l;
        if (l == 0) phase_conv(c, (float*)lds_raw, 0, c.bid, c.G, 0, CT_ALL, true); else phase_conv(c, (float*)lds_raw, 1, c.bid, c.G, CT_EARLY, CT_ALL, false);
        GSYNC();
        { const bf16_t* hin = (l == 0) ? c.w<bf16_t>(WS_HB) : (const bf16_t*)c.out(); pg8::Gemm g{hin, c.w<bf16_t>(WS_WIN), MTOK, NZ, DM, DM}; pg8::StaticOrder S; S.init(MTOK, NZ, c.G, c.bid);
          pg8::EpiZ E{c.w<bf16_t>(WS_Z), c.w<float>(WS_ROWSS) + (size_t)(3 * l) * MTOK};
          pg8::gemm_phase<pg8::EpiZ>(lds, g, S, E);
          small_proj(c, (l == 0) ? c.w<bf16_t>(WS_HB) : (const bf16_t*)c.out(), c.w<float>(WS_ROWSS) + (size_t)(3 * l) * MTOK); }
        GSYNC();
        phase_m1(c, lds_raw);
        GSYNC();
        phase_m2(c, lds_raw);
        GSYNC();
        phase_m2b(c);
        GSYNC();
        phase_m3(c, lds_raw);
        GSYNC();
        { pg8::Gemm g{c.w<bf16_t>(WS_Z), c.w<bf16_t>(WS_WOUT), MTOK, DM, DM, NZ}; pg8::StaticOrder S; S.init(MTOK, DM, c.G, c.bid);
          pg8::EpiRes E{l == 0 ? c.in(I_X) : (const float*)nullptr, (const bf16_t*)c.out(), c.w<bf16_t>(WS_HB), c.w<float>(WS_ROWSS) + (size_t)(3 * l + 1) * MTOK};
          pg8::gemm_phase<pg8::EpiRes>(lds, g, S, E); }
        GSYNC();
        { pg8::Gemm g{c.w<bf16_t>(WS_HB), c.w<bf16_t>(WS_WUP), MTOK, NUP, DM, DM}; pg8::StaticOrder S; S.init(MTOK, NUP, c.G, c.bid);
          pg8::EpiAct E{c.w<bf16_t>(WS_ACT), c.w<float>(WS_ROWSS) + (size_t)(3 * l + 1) * MTOK};
          pg8::gemm_phase<pg8::EpiAct>(lds, g, S, E);
          { const int hG = c.G / 2; if (c.bid >= hG) { phase_pb(c, c.bid - hG, c.G - hG); if (l == 0) phase_conv(c, (float*)lds_raw, 1, c.bid - hG, c.G - hG, 0, CT_EARLY, true); } } }
        GSYNC();
        { pg8::Gemm g{c.w<bf16_t>(WS_ACT), c.w<bf16_t>(WS_WDN), MTOK, DM, FF, FF}; pg8::StaticOrder S; S.init(MTOK, DM, c.G, c.bid);
          pg8::EpiRes E{(const float*)nullptr, c.w<bf16_t>(WS_HB), c.w<bf16_t>(WS_HB), c.w<float>(WS_ROWSS) + (size_t)(3 * l + 2) * MTOK};
          pg8::gemm_phase<pg8::EpiRes>(lds, g, S, E);
        }
        GSYNC();
        { pg8::StaticOrder S; S.init(MTOK, DM, c.G, c.bid);
          pg8::Gemm g1{c.w<bf16_t>(WS_PB), c.w<bf16_t>(WS_WPP), MTOK, DM, PLED, PLED};
          pg8::EpiTmp E1{c.w<bf16_t>(WS_TMP)};
          pg8::gemm_phase<pg8::EpiTmp>(lds, g1, S, E1);
          pg8::Gemm g2{c.w<bf16_t>(WS_HB), c.w<bf16_t>(WS_WPG), MTOK, DM, DM, DM};
          pg8::EpiPle E2{c.w<bf16_t>(WS_TMP), c.w<bf16_t>(WS_HB), (l == 0) ? (bf16_t*)c.out() : c.w<bf16_t>(WS_HB2), c.w<float>(WS_ROWSS) + (size_t)(3 * l + 2) * MTOK, c.w<float>(WS_ROWSS) + (size_t)(3 * l + 3) * MTOK, (l == 0) ? (float*)nullptr : c.out()};
          pg8::gemm_phase<pg8::EpiPle>(lds, g2, S, E2); }
        GSYNC();
        }
    phase_final(c);
}

extern "C" void kernel_launch(void* const* d_in, const int* in_sizes, int n_in, void* d_out, int out_size, void* d_ws, size_t ws_size, hipStream_t stream) {
    static int grid_blocks = 0;
    if (grid_blocks == 0) {
        if (n_in != 31 || ws_size < WS_TOTAL) { fprintf(stderr, "kernel_launch: n_in %d ws %zu (need %zu)\n", n_in, ws_size, (size_t)WS_TOTAL); grid_blocks = -1; return; }
        int dev = 0, cus = 0, per_cu = 0;
        hipGetDevice(&dev); hipDeviceGetAttribute(&cus, hipDeviceAttributeMultiprocessorCount, dev);
        hipFuncSetAttribute((const void*)mega_fwd, hipFuncAttributeMaxDynamicSharedMemorySize, LDS_BYTES);
        hipOccupancyMaxActiveBlocksPerMultiprocessor(&per_cu, (const void*)mega_fwd, NTHR, LDS_BYTES);
        if (per_cu < 1) { fprintf(stderr, "kernel_launch: occupancy query says %d blocks/CU\n", per_cu); per_cu = 1; }
        grid_blocks = cus * 1;
        (void)hipGetLastError();
    }
    if (grid_blocks < 0) return;
    Params p{};
    for (int i = 0; i < 31; ++i) p.in[i] = (const float*)d_in[i];
    p.out = (float*)d_out; p.ws = (unsigned char*)d_ws;
    (void)hipMemsetAsync((unsigned char*)d_ws + WS_BAR, 0, 16384, stream);
    void* args[] = {&p};
    hipError_t e = hipLaunchCooperativeKernel((const void*)mega_fwd, dim3(grid_blocks), dim3(NTHR), args, LDS_BYTES, stream);
    if (e != hipSuccess) fprintf(stderr, "cooperative launch failed: %s (grid %d)\n", hipGetErrorString(e), grid_blocks);
}
```

```cpp
#include <hip/hip_runtime.h>
#include <hip/hip_cooperative_groups.h>
#include <cstdio>
namespace cg = cooperative_groups;

#define LAS __attribute__((address_space(3)))
#define GAS __attribute__((address_space(1)))
typedef unsigned short bf16_t;
typedef short bf16x8 __attribute__((ext_vector_type(8)));
typedef float f32x4 __attribute__((ext_vector_type(4)));
typedef float f32x2 __attribute__((ext_vector_type(2)));
typedef unsigned u32x4 __attribute__((ext_vector_type(4)));
typedef unsigned u32x2 __attribute__((ext_vector_type(2)));

constexpr int MTOK = 16384, DM = 1024, SEQL = 2048, NCH = 32, NZ = 3072, INW = 3096, FF = 2816, NUP = 5632, PLED = 256;
constexpr float EPSF = 1e-6f;
constexpr int NTHR = 512;
constexpr int LDS_BYTES = 147456;
constexpr int ZC_AV = 0, ZC_SU = 256, ZC_RV = 512, ZC_DV = 768, ZC_AQ = 1024, ZC_AK = 1152, ZC_AR = 1280, ZC_RQ = 1536, ZC_RK = 1792, ZC_RG = 2048, ZC_DQ = 2304, ZC_DK = 2560, ZC_DG = 2816;

constexpr size_t al256(size_t x) { return (x + 255) & ~(size_t)255; }
constexpr size_t WS_WIN = 0;
constexpr size_t WS_WSM = WS_WIN + (size_t)NZ * DM * 2;
constexpr size_t WS_WOUT = WS_WSM + (size_t)32 * DM * 2;
constexpr size_t WS_WUP = WS_WOUT + (size_t)DM * DM * 2;
constexpr size_t WS_WDN = WS_WUP + (size_t)NUP * DM * 2;
constexpr size_t WS_WPG = WS_WDN + (size_t)DM * FF * 2;
constexpr size_t WS_WPP = WS_WPG + (size_t)DM * DM * 2;
constexpr size_t WS_WGLU = WS_WPP + (size_t)DM * PLED * 2;
constexpr size_t WS_S5A = WS_WGLU + (size_t)256 * 256 * 2;
constexpr size_t WS_S5BB = WS_S5A + 4 * 1024 * 4;
constexpr size_t WS_HB = WS_S5BB + (size_t)16 * 64 * 32 * 4;
constexpr size_t WS_ROWSS = WS_HB + (size_t)MTOK * DM * 2;
constexpr size_t WS_ZS = WS_ROWSS + (size_t)7 * MTOK * 8;
constexpr size_t WS_GDL = WS_ZS + (size_t)MTOK * 32 * 4;
constexpr size_t WS_GLDEC = WS_GDL + 1024 * 4;
constexpr size_t WS_BIG = al256(WS_GLDEC + 1024 * 32 * 4);
constexpr size_t WS_Z = WS_BIG;
constexpr size_t WS_GU = WS_Z + (size_t)MTOK * NZ * 2;
constexpr size_t WS_GW = WS_GU + (size_t)1024 * 4096 * 4;
constexpr size_t WS_GA = WS_GW + (size_t)1024 * 4096 * 4;
constexpr size_t WS_GQD = WS_GA + (size_t)1024 * 4096 * 4;
constexpr size_t WS_GKE = WS_GQD + (size_t)1024 * 4096 * 2;
constexpr size_t WS_RDS = WS_GKE + (size_t)1024 * 4096 * 2;
constexpr size_t WS_ADS = WS_RDS + (size_t)1024 * 4096 * 4;
constexpr size_t WS_S5E = WS_ADS + (size_t)1024 * 2048 * 4;
constexpr size_t WS_END = WS_S5E + (size_t)8 * 16 * 32 * 64 * 8;
constexpr size_t WS_BAR = al256(WS_END);
constexpr size_t WS_TOTAL = WS_BAR + 16384;
constexpr size_t WS_ACT = WS_BIG;
constexpr size_t WS_PB = WS_BIG + (size_t)100663296;
constexpr size_t WS_TMP = WS_BIG;
constexpr size_t WS_HB2 = WS_BIG + (size_t)115343360;
static_assert(WS_PB + (size_t)MTOK * PLED * 2 <= WS_HB2 && WS_HB2 + (size_t)MTOK * DM * 2 <= WS_END, "hb2 placement");
static_assert((size_t)MTOK * FF * 2 <= 100663296, "act fits under PB");
static_assert(WS_PB + (size_t)MTOK * PLED * 2 <= WS_END, "pb inside");

struct Params {
    const float* in[31];
    float* out;
    unsigned char* ws;
};
enum { I_X = 0, I_P, I_POS, I_NMIX, I_WIN, I_WOUT, I_GLA_WA2, I_GLA_BA, I_GLA_NORM, I_S5_LRE, I_S5_LIM, I_S5_LOGDT, I_S5_BRE, I_S5_BIM, I_S5_CRE, I_S5_CIM,
       I_S5_D, I_S5_WGLU, I_S5_BGLU, I_RET_NORM, I_GDN_CONV, I_GDN_ALOG, I_GDN_DTB, I_GDN_NORM, I_NFFN, I_WUP, I_WDN, I_NPLE, I_WPG, I_WPP, I_NFINAL };

__device__ __forceinline__ unsigned f2bf(float f) { unsigned u = __builtin_bit_cast(unsigned, f); return (u + 0x7fffu + ((u >> 16) & 1u)) >> 16; }
__device__ __forceinline__ unsigned pk2(float lo, float hi) { return f2bf(lo) | (f2bf(hi) << 16); }
__device__ __forceinline__ float bf_lo(unsigned w) { return __builtin_bit_cast(float, w << 16); }
__device__ __forceinline__ float bf_hi(unsigned w) { return __builtin_bit_cast(float, w & 0xffff0000u); }
__device__ __forceinline__ float bf2f(bf16_t v) { return __builtin_bit_cast(float, ((unsigned)v) << 16); }
__device__ __forceinline__ void unpack8(u32x4 w, float* v) { v[0] = bf_lo(w.x); v[1] = bf_hi(w.x); v[2] = bf_lo(w.y); v[3] = bf_hi(w.y); v[4] = bf_lo(w.z); v[5] = bf_hi(w.z); v[6] = bf_lo(w.w); v[7] = bf_hi(w.w); }
__device__ __forceinline__ u32x4 pack8(const float* v) { u32x4 w; w.x = pk2(v[0], v[1]); w.y = pk2(v[2], v[3]); w.z = pk2(v[4], v[5]); w.w = pk2(v[6], v[7]); return w; }
__device__ __forceinline__ float sigm(float x) { return 1.f / (1.f + __expf(-x)); }
__device__ __forceinline__ float siluf(float x) { return x / (1.f + __expf(-x)); }
__device__ __forceinline__ float softplusf(float x) { return fmaxf(x, 0.f) + __logf(1.f + __expf(-fabsf(x))); }
__device__ __forceinline__ float gelu_tanh(float y) { float t = 0.7978845608028654f * (y + 0.044715f * y * y * y); float e = __expf(2.f * t); float th = 1.f - 2.f / (e + 1.f); return 0.5f * y * (1.f + th); }
__device__ __forceinline__ void sincos_d(double a, float& s, float& c) {
    double kd = rint(a * 0.6366197723675814); float r = (float)(a - kd * 1.5707963267948966);
    int q = ((int)(long long)kd) & 3; float r2 = r * r;
    float sn = r + r * r2 * (-1.6666667e-1f + r2 * (8.3333333e-3f + r2 * (-1.9841270e-4f + r2 * 2.7557319e-6f)));
    float cs = 1.f + r2 * (-0.5f + r2 * (4.1666667e-2f + r2 * (-1.3888889e-3f + r2 * 2.4801587e-5f)));
    float s0 = (q & 1) ? cs : sn, c0 = (q & 1) ? sn : cs;
    s = (q & 2) ? -s0 : s0; c = (q == 1 || q == 2) ? -c0 : c0;
}
#define LBAR() do { asm volatile("s_waitcnt lgkmcnt(0)" ::: "memory"); __builtin_amdgcn_s_barrier(); asm volatile("" ::: "memory"); } while (0)
__device__ __forceinline__ int ltid() { int t = threadIdx.x; asm volatile("" : "+v"(t)); return t; }
__device__ __forceinline__ int lsg(int x) { asm volatile("" : "+s"(x)); return x; }
typedef unsigned u64_t;
constexpr float SS_SCALE = 64.f, SS_INV = 1.f / (64.f * DM);
__device__ __forceinline__ float row_rs(const float* rowss, int row) { const u64_t v = ((const GAS u64_t*)rowss)[row]; return rsqrtf((float)v * SS_INV + EPSF); }
__device__ __forceinline__ void row_ss_add(float* rowss, int row, float ss) { __hip_atomic_fetch_add((GAS u64_t*)rowss + row, (u64_t)(ss * SS_SCALE + 0.5f), __ATOMIC_RELAXED, __HIP_MEMORY_SCOPE_AGENT); }
__device__ __forceinline__ f32x4 mm16(const float* A, int ars, int aks, const float* B, int bks, int bcs, int K, f32x4 acc, int lane) {
    const float* ap = A + (lane & 15) * ars + (lane >> 4) * aks;
    const float* bp = B + (lane >> 4) * bks + (lane & 15) * bcs;
    f32x4 acc2 = {0.f, 0.f, 0.f, 0.f}; const int Kh = K >> 1;
#pragma unroll 2
    for (int k = 0; k < Kh; k += 4) { acc = __builtin_amdgcn_mfma_f32_16x16x4f32(ap[k * aks], bp[k * bks], acc, 0, 0, 0);
        acc2 = __builtin_amdgcn_mfma_f32_16x16x4f32(ap[(k + Kh) * aks], bp[(k + Kh) * bks], acc2, 0, 0, 0); }
    return acc + acc2;
}
template <bool BC>
__device__ __forceinline__ f32x4 mm16v(const float* A, int ap, const float* B, int bp, int K, f32x4 acc, int lane) {
    const int i = lane & 15, q = lane >> 4;
    const float* apn = A + i * ap + 4 * q;
    const float* bpn = BC ? (B + i * bp + 4 * q) : (B + (4 * q) * bp + i);
    f32x4 acc2 = {0.f, 0.f, 0.f, 0.f};
#pragma unroll 2
    for (int c = 0; c < K; c += 16) {
        const f32x4 a4 = *(const f32x4*)(apn + c);
        f32x4 b4;
        if (BC) b4 = *(const f32x4*)(bpn + c);
        else { b4[0] = bpn[c * bp]; b4[1] = bpn[(c + 1) * bp]; b4[2] = bpn[(c + 2) * bp]; b4[3] = bpn[(c + 3) * bp]; }
        if (c & 16) {
#pragma unroll
            for (int e = 0; e < 4; ++e) acc2 = __builtin_amdgcn_mfma_f32_16x16x4f32(a4[e], b4[e], acc2, 0, 0, 0);
        } else {
#pragma unroll
            for (int e = 0; e < 4; ++e) acc = __builtin_amdgcn_mfma_f32_16x16x4f32(a4[e], b4[e], acc, 0, 0, 0);
        }
    }
    return acc + acc2;
}
template <bool BC>
__device__ __forceinline__ void mm16v2(const float* A, int ap, const float* B, int bp, int K, f32x4& acc0, f32x4& acc1, int lane) {
    const int i = lane & 15, q = lane >> 4;
    const float* apn = A + i * ap + 4 * q;
    const float* bpn = BC ? (B + (2 * i) * bp + 4 * q) : (B + (4 * q) * bp + 2 * i);
#pragma unroll 2
    for (int c = 0; c < K; c += 16) {
        const f32x4 a4 = *(const f32x4*)(apn + c);
        if (BC) { const f32x4 x0 = *(const f32x4*)(bpn + c), x1 = *(const f32x4*)(bpn + bp + c);
#pragma unroll
            for (int e = 0; e < 4; ++e) { acc0 = __builtin_amdgcn_mfma_f32_16x16x4f32(a4[e], x0[e], acc0, 0, 0, 0); acc1 = __builtin_amdgcn_mfma_f32_16x16x4f32(a4[e], x1[e], acc1, 0, 0, 0); } }
        else { f32x2 bb[4];
#pragma unroll
            for (int e = 0; e < 4; ++e) bb[e] = *(const f32x2*)(bpn + (c + e) * bp);
#pragma unroll
            for (int e = 0; e < 4; ++e) { acc0 = __builtin_amdgcn_mfma_f32_16x16x4f32(a4[e], bb[e][0], acc0, 0, 0, 0); acc1 = __builtin_amdgcn_mfma_f32_16x16x4f32(a4[e], bb[e][1], acc1, 0, 0, 0); } }
    }
}
__device__ __forceinline__ void mm16t2(const float* A, int ap, const float* B, int bp, int K, f32x4& acc0, f32x4& acc1, int lane) {
    const int i = lane & 15, q = lane >> 4;
    const float* apn = A + (4 * q) * ap + i; const float* bpn = B + (4 * q) * bp + 2 * i;
#pragma unroll 2
    for (int c = 0; c < K; c += 16) { float a4[4]; f32x2 bb[4];
#pragma unroll
        for (int e = 0; e < 4; ++e) { a4[e] = apn[(c + e) * ap]; bb[e] = *(const f32x2*)(bpn + (c + e) * bp); }
#pragma unroll
        for (int e = 0; e < 4; ++e) { acc0 = __builtin_amdgcn_mfma_f32_16x16x4f32(a4[e], bb[e][0], acc0, 0, 0, 0); acc1 = __builtin_amdgcn_mfma_f32_16x16x4f32(a4[e], bb[e][1], acc1, 0, 0, 0); } }
}
__device__ __forceinline__ void ld_tile64(float* dst, const bf16_t* src, size_t pitch, int tid) {
    const int r = tid >> 3, c8 = (tid & 7) * 8; float v[8];
    unpack8(*(const u32x4*)(src + (size_t)r * pitch + c8), v);
    float* d = dst + r * 68 + c8;
    *(f32x4*)d = (f32x4){v[0], v[1], v[2], v[3]}; *(f32x4*)(d + 4) = (f32x4){v[4], v[5], v[6], v[7]};
}
__device__ __forceinline__ u32x4 ldg_tile64(const bf16_t* src, size_t pitch, int tid) { return *(const u32x4*)(src + (size_t)(tid >> 3) * pitch + (tid & 7) * 8); }
__device__ __forceinline__ void st_tile64(float* dst, u32x4 w, int tid) { const int r = tid >> 3, c8 = (tid & 7) * 8; float v[8]; unpack8(w, v); float* d = dst + r * 68 + c8;
    *(f32x4*)d = (f32x4){v[0], v[1], v[2], v[3]}; *(f32x4*)(d + 4) = (f32x4){v[4], v[5], v[6], v[7]}; }
__device__ __forceinline__ u32x4 ldg_tile64x32(const bf16_t* src, int tid) { const int t = tid & 255; return *(const u32x4*)(src + (size_t)(t >> 2) * NZ + (t & 3) * 8); }
__device__ __forceinline__ void st_tile64x32(float* dst, u32x4 w, int tid) { if (tid < 256) { const int r = tid >> 2, c8 = (tid & 3) * 8; float v[8]; unpack8(w, v); float* d = dst + r * 36 + c8;
    *(f32x4*)d = (f32x4){v[0], v[1], v[2], v[3]}; *(f32x4*)(d + 4) = (f32x4){v[4], v[5], v[6], v[7]}; } }
__device__ __forceinline__ void ld_tile64f(float* dst, const float* src, int tid) {
    const int r = tid >> 3, c8 = (tid & 7) * 8;
    f32x4 a = *(const f32x4*)(src + r * 64 + c8), b = *(const f32x4*)(src + r * 64 + c8 + 4);
    *(f32x4*)(dst + r * 68 + c8) = a; *(f32x4*)(dst + r * 68 + c8 + 4) = b;
}

namespace pg8 {
constexpr int BM = 256, BK = 64, HALF = 128, HTB = HALF * BK * 2, NXCD = 8, WGM = 8;
__device__ __forceinline__ int lds_byte(int r, int c) { const int st = (r >> 4) * 2 + (c >> 5), rr = r & 15, cc = c & 31, ob = rr * 64 + cc * 2; return st * 1024 + (ob ^ (((ob >> 9) & 1) << 5)); }
__device__ __forceinline__ void stage_rc(int b, int& R, int& C) { const int st = b / 1024, sb = b % 1024, swz = sb ^ (((sb >> 9) & 1) << 5); R = (st >> 1) * 16 + swz / 64; C = (st & 1) * 32 + (swz % 64) / 2; }
__device__ __forceinline__ int perm32(int rho) { const int n = rho >> 4, i = rho & 15; return 8 * (i >> 2) + 4 * n + (i & 3); }
struct Unit { int pm, pn; };
struct Gemm { const bf16_t* A; const bf16_t* Bt; int M, N, K, lda; };
struct StaticOrder {
    int nM, nN, nwg, G, c;
    __device__ void init(int M, int N, int G_, int c_) { nM = M / BM; nN = N / BM; nwg = nM * nN; G = G_; c = c_; }
    __device__ bool next(int i, Unit& u) const {
        const long L = (long)i * G + c; if (L >= nwg) return false;
        int wgid = (int)L; { const int q = nwg / NXCD, r = nwg % NXCD, xcd = wgid % NXCD, off = wgid / NXCD; wgid = (xcd < r ? xcd * (q + 1) : r * (q + 1) + (xcd - r) * q) + off; }
        const int nig = WGM * nN, gid = wgid / nig, fm = gid * WGM, gsz = (nM - fm) < WGM ? (nM - fm) : WGM;
        u.pm = fm + ((wgid % nig) % gsz); u.pn = (wgid % nig) / gsz; return true;
    }
};

template <class Epi>
__device__ __forceinline__ void gemm_phase(LAS unsigned char* lds, const Gemm g, const StaticOrder& S, const Epi& E) {
    const int tid = ltid(), wid = __builtin_amdgcn_readfirstlane(tid >> 6), lane = tid & 63, wr = wid >> 2, wc = wid & 3, fr = lane & 15, fq = lane >> 4;
    const int K = g.K, nt = K / BK, lda = g.lda;
    unsigned voffA[2], voffB[2];
#pragma unroll
    for (int i = 0; i < 2; ++i) { int R, C; stage_rc(tid * 16 + i * 8192, R, C); const int Rb = Epi::PERM ? ((R & ~31) + perm32(R & 31)) : R;
        voffA[i] = (unsigned)(R * lda + C) * 2u; voffB[i] = (unsigned)(Rb * K + C) * 2u; }
    const size_t kstep = (size_t)(BK * 2);
    const size_t hstepA = (size_t)HALF * lda * 2, hstepB = (size_t)HALF * K * 2;
    const size_t tstepA = 2 * hstepA, tstepB = 2 * hstepB;
    const unsigned ldsw = (unsigned)wid * 1024u;
    const int aoff = lds_byte(wr * 64 + fr, fq * 8), boff = lds_byte(wc * 32 + fr, fq * 8);
#define PG8_SA(b, h) (((b) * 2 + (h)) * HTB)
#define PG8_SB(b, h) ((4 + (b) * 2 + (h)) * HTB)
#define PG8_STAGE(bufoff, gbase, voff) do { _Pragma("unroll") for (int _i = 0; _i < 2; ++_i) \
        __builtin_amdgcn_global_load_lds((const unsigned*)((const char*)(gbase) + (voff)[_i]), (LAS unsigned*)(lds + (bufoff) + ldsw + _i * 8192), 16, 0, 0); } while (0)
#define PG8_LDA(dst, b, h) do { _Pragma("unroll") for (int m = 0; m < 4; ++m) _Pragma("unroll") for (int k = 0; k < 2; ++k) dst[m][k] = *(const LAS bf16x8*)(lds + PG8_SA(b, h) + aoff + m * 2048 + k * 1024); } while (0)
#define PG8_LDB(dst, b, h) do { _Pragma("unroll") for (int n = 0; n < 2; ++n) _Pragma("unroll") for (int k = 0; k < 2; ++k) dst[n][k] = *(const LAS bf16x8*)(lds + PG8_SB(b, h) + boff + n * 2048 + k * 1024); } while (0)
#define PG8_MMA(ai, bj, At, Bt) do { __builtin_amdgcn_s_setprio(1); _Pragma("unroll") for (int m = 0; m < 4; ++m) _Pragma("unroll") for (int n = 0; n < 2; ++n) _Pragma("unroll") for (int k = 0; k < 2; ++k) \
        acc[ai][bj][m][n] = __builtin_amdgcn_mfma_f32_16x16x32_bf16(Bt[n][k], At[m][k], acc[ai][bj][m][n], 0, 0, 0); __builtin_amdgcn_s_setprio(0); } while (0)
#define PG8_WAIT_V(n) asm volatile("s_waitcnt vmcnt(" #n ")" ::: "memory")
#define PG8_WAIT_L(n) asm volatile("s_waitcnt lgkmcnt(" #n ")" ::: "memory")
#define PG8_BAR __builtin_amdgcn_s_barrier()
#define PG8_SCHED __builtin_amdgcn_sched_barrier(0)
    Unit cur, nxt; int ui = 0;
    if (!S.next(0, cur)) return;
    f32x4 acc[2][2][4][2];
#pragma unroll
    for (int a = 0; a < 2; ++a)
#pragma unroll
        for (int b = 0; b < 2; ++b)
#pragma unroll
            for (int m = 0; m < 4; ++m)
#pragma unroll
                for (int n = 0; n < 2; ++n) acc[a][b][m][n] = (f32x4){0.f, 0.f, 0.f, 0.f};
    bf16x8 At[4][2], B0[2][2], B1[2][2];
    const char* cA = (const char*)g.A + (size_t)cur.pm * tstepA; const char* cB = (const char*)g.Bt + (size_t)cur.pn * tstepB;
    PG8_STAGE(PG8_SB(0, 0), cB, voffB); PG8_STAGE(PG8_SA(0, 0), cA, voffA); PG8_STAGE(PG8_SB(0, 1), cB + hstepB, voffB); PG8_STAGE(PG8_SA(0, 1), cA + hstepA, voffA);
    if (wr == 1) PG8_BAR;
    PG8_WAIT_V(4); PG8_BAR;
    PG8_STAGE(PG8_SB(1, 0), cB + kstep, voffB); PG8_STAGE(PG8_SA(1, 0), cA + kstep, voffA); PG8_STAGE(PG8_SB(1, 1), cB + hstepB + kstep, voffB);
    PG8_WAIT_V(6); PG8_BAR;
    for (;;) {
        const bool has_next = S.next(ui + 1, nxt);
        const char* nA = has_next ? (const char*)g.A + (size_t)nxt.pm * tstepA : cA; const char* nB = has_next ? (const char*)g.Bt + (size_t)nxt.pn * tstepB : cB;
        for (int t = 0; t < nt; t += 2) {
            const bool last = (t == nt - 2);
            const char* a1 = cA + (size_t)(t + 1) * kstep;
            const char* a2 = last ? nA : cA + (size_t)(t + 2) * kstep; const char* b2 = last ? nB : cB + (size_t)(t + 2) * kstep;
            const char* a3 = a2 + kstep; const char* b3 = b2 + kstep;
            PG8_LDB(B0, 0, 0); PG8_SCHED; PG8_LDA(At, 0, 0); PG8_STAGE(PG8_SA(1, 1), a1 + hstepA, voffA);
            PG8_WAIT_L(8); PG8_BAR; PG8_WAIT_L(0); PG8_MMA(0, 0, At, B0); PG8_BAR; PG8_SCHED;
            PG8_LDB(B1, 0, 1); PG8_STAGE(PG8_SB(0, 0), b2, voffB);
            PG8_BAR; PG8_WAIT_L(0); PG8_MMA(0, 1, At, B1); PG8_BAR;
            PG8_LDA(At, 0, 1); PG8_STAGE(PG8_SA(0, 0), a2, voffA);
            PG8_BAR; PG8_WAIT_L(0); PG8_MMA(1, 0, At, B0); PG8_BAR; PG8_SCHED;
            PG8_STAGE(PG8_SB(0, 1), b2 + hstepB, voffB);
            PG8_WAIT_V(6); PG8_BAR; PG8_MMA(1, 1, At, B1); PG8_BAR;
            PG8_LDB(B0, 1, 0); PG8_SCHED; PG8_LDA(At, 1, 0); PG8_STAGE(PG8_SA(0, 1), a2 + hstepA, voffA);
            PG8_WAIT_L(8); PG8_BAR; PG8_WAIT_L(0); PG8_MMA(0, 0, At, B0); PG8_BAR; PG8_SCHED;
            PG8_LDB(B1, 1, 1); PG8_STAGE(PG8_SB(1, 0), b3, voffB);
            PG8_BAR; PG8_WAIT_L(0); PG8_MMA(0, 1, At, B1); PG8_BAR;
            PG8_LDA(At, 1, 1); PG8_STAGE(PG8_SA(1, 0), a3, voffA);
            PG8_BAR; PG8_WAIT_L(0); PG8_MMA(1, 0, At, B0); PG8_BAR; PG8_SCHED;
            PG8_STAGE(PG8_SB(1, 1), b3 + hstepB, voffB);
            PG8_WAIT_V(6); PG8_BAR; PG8_MMA(1, 1, At, B1); PG8_BAR;
        }
        E(acc, cur, wr, wc, fr, fq);
        if (!has_next) break;
#pragma unroll
        for (int a = 0; a < 2; ++a)
#pragma unroll
            for (int b = 0; b < 2; ++b)
#pragma unroll
                for (int m = 0; m < 4; ++m)
#pragma unroll
                    for (int n = 0; n < 2; ++n) acc[a][b][m][n] = (f32x4){0.f, 0.f, 0.f, 0.f};
        cur = nxt; cA = nA; cB = nB; ++ui;
    }
    PG8_WAIT_V(0);
    if (wr == 0) PG8_BAR;
    PG8_BAR;
#undef PG8_SA
#undef PG8_SB
#undef PG8_STAGE
#undef PG8_LDA
#undef PG8_LDB
#undef PG8_MMA
#undef PG8_WAIT_V
#undef PG8_WAIT_L
#undef PG8_BAR
#undef PG8_SCHED
}

struct EpiZ {
    static constexpr bool PERM = true;
    bf16_t* Z; const float* rowss;
    __device__ __forceinline__ void operator()(const f32x4 (&acc)[2][2][4][2], const Unit& u, int wr, int wc, int fr, int fq) const {
        const int row0 = u.pm * BM + wr * 64 + fr, col0 = u.pn * BM + wc * 32 + 8 * fq;
#pragma unroll
        for (int ai = 0; ai < 2; ++ai)
#pragma unroll
            for (int m = 0; m < 4; ++m) { const int row = row0 + ai * HALF + m * 16; const float rs = row_rs(rowss, row);
                GAS bf16_t* rowp = (GAS bf16_t*)Z + (size_t)row * NZ + col0;
#pragma unroll
                for (int bj = 0; bj < 2; ++bj) { const f32x4 v0 = acc[ai][bj][m][0] * rs, v1 = acc[ai][bj][m][1] * rs;
                    u32x4 w; w.x = pk2(v0[0], v0[1]); w.y = pk2(v0[2], v0[3]); w.z = pk2(v1[0], v1[1]); w.w = pk2(v1[2], v1[3]);
                    *(GAS u32x4*)(rowp + bj * HALF) = w; } }
    }
};
struct EpiAct {
    static constexpr bool PERM = true;
    bf16_t* O; const float* rowss;
    __device__ __forceinline__ void operator()(const f32x4 (&acc)[2][2][4][2], const Unit& u, int wr, int wc, int fr, int fq) const {
        const int row0 = u.pm * BM + wr * 64 + fr, col0 = u.pn * HALF + wc * 32 + 8 * fq;
#pragma unroll
        for (int ai = 0; ai < 2; ++ai)
#pragma unroll
            for (int m = 0; m < 4; ++m) { const int row = row0 + ai * HALF + m * 16; const float rs = row_rs(rowss, row);
                float o[8];
#pragma unroll
                for (int n = 0; n < 2; ++n)
#pragma unroll
                    for (int j = 0; j < 4; ++j) { const float gg = acc[ai][0][m][n][j] * rs, uu = acc[ai][1][m][n][j] * rs; o[n * 4 + j] = siluf(gg) * uu; }
                *(GAS u32x4*)((GAS bf16_t*)O + (size_t)row * FF + col0) = pack8(o); }
    }
};
struct EpiRes {
    static constexpr bool PERM = false;
    const float* xbase; const bf16_t* hbase; bf16_t* hout; float* rowss_next;
    __device__ __forceinline__ void operator()(const f32x4 (&acc)[2][2][4][2], const Unit& u, int wr, int wc, int fr, int fq) const {
        const int row0 = u.pm * BM + wr * 64 + fr, col0 = u.pn * BM + wc * 32 + 4 * fq;
#pragma unroll
        for (int ai = 0; ai < 2; ++ai)
#pragma unroll
            for (int m = 0; m < 4; ++m) { const int row = row0 + ai * HALF + m * 16; const size_t off = (size_t)row * DM + col0; float ss = 0.f;
#pragma unroll
                for (int bj = 0; bj < 2; ++bj)
#pragma unroll
                    for (int n = 0; n < 2; ++n) { f32x4 bs;
                        if (xbase) bs = *(const GAS f32x4*)((const GAS float*)xbase + off + bj * HALF + n * 16);
                        else { const u32x2 hw = *(const GAS u32x2*)((const GAS bf16_t*)hbase + off + bj * HALF + n * 16); bs = (f32x4){bf_lo(hw.x), bf_hi(hw.x), bf_lo(hw.y), bf_hi(hw.y)}; }
                        const f32x4 o = bs + acc[ai][bj][m][n];
                        u32x2 w; w.x = pk2(o[0], o[1]); w.y = pk2(o[2], o[3]); *(GAS u32x2*)((GAS bf16_t*)hout + off + bj * HALF + n * 16) = w;
                        ss += (o[0] * o[0] + o[1] * o[1]) + (o[2] * o[2] + o[3] * o[3]); }
                ss += __shfl_xor(ss, 16); ss += __shfl_xor(ss, 32);
                if (fq == 0) row_ss_add(rowss_next, row, ss);
                asm volatile("" ::: "memory"); }
    }
};
struct EpiTmp {
    static constexpr bool PERM = false;
    bf16_t* C;
    __device__ __forceinline__ void operator()(const f32x4 (&acc)[2][2][4][2], const Unit& u, int wr, int wc, int fr, int fq) const {
        const int row0 = u.pm * BM + wr * 64 + fr, col0 = u.pn * BM + wc * 32 + 4 * fq;
#pragma unroll
        for (int ai = 0; ai < 2; ++ai)
#pragma unroll
            for (int m = 0; m < 4; ++m) { GAS bf16_t* rowp = (GAS bf16_t*)C + (size_t)(row0 + ai * HALF + m * 16) * DM + col0;
#pragma unroll
                for (int bj = 0; bj < 2; ++bj)
#pragma unroll
                    for (int n = 0; n < 2; ++n) { const f32x4 o = acc[ai][bj][m][n]; u32x2 w; w.x = pk2(o[0], o[1]); w.y = pk2(o[2], o[3]); *(GAS u32x2*)(rowp + bj * HALF + n * 16) = w; } }
    }
};
struct EpiPle {
    static constexpr bool PERM = false;
    const bf16_t* tmp; const bf16_t* hin; bf16_t* hout; const float* rowss; float* rowss_next; float* hout32;
    __device__ __forceinline__ void operator()(const f32x4 (&acc)[2][2][4][2], const Unit& u, int wr, int wc, int fr, int fq) const {
        const int row0 = u.pm * BM + wr * 64 + fr, col0 = u.pn * BM + wc * 32 + 4 * fq;
#pragma unroll
        for (int ai = 0; ai < 2; ++ai)
#pragma unroll
            for (int m = 0; m < 4; ++m) { const int row = row0 + ai * HALF + m * 16; const size_t off = (size_t)row * DM + col0; float ss = 0.f;
                const float rs = row_rs(rowss, row);
#pragma unroll
                for (int bj = 0; bj < 2; ++bj)
#pragma unroll
                    for (int n = 0; n < 2; ++n) { const u32x2 hw = *(const GAS u32x2*)((const GAS bf16_t*)hin + off + bj * HALF + n * 16); const u32x2 tw = *(const GAS u32x2*)((const GAS bf16_t*)tmp + off + bj * HALF + n * 16);
                        const f32x4 bs = {bf_lo(hw.x), bf_hi(hw.x), bf_lo(hw.y), bf_hi(hw.y)}; const f32x4 pr = {bf_lo(tw.x), bf_hi(tw.x), bf_lo(tw.y), bf_hi(tw.y)};
                        f32x4 o;
#pragma unroll
                        for (int j = 0; j < 4; ++j) o[j] = bs[j] + pr[j] * sigm(acc[ai][bj][m][n][j] * rs);
                        u32x2 w; w.x = pk2(o[0], o[1]); w.y = pk2(o[2], o[3]); if (hout32) *(GAS f32x4*)((GAS float*)hout32 + off + bj * HALF + n * 16) = o; else *(GAS u32x2*)((GAS bf16_t*)hout + off + bj * HALF + n * 16) = w;
                        ss += (o[0] * o[0] + o[1] * o[1]) + (o[2] * o[2] + o[3] * o[3]); }
                ss += __shfl_xor(ss, 16); ss += __shfl_xor(ss, 32);
                if (fq == 0) row_ss_add(rowss_next, row, ss);
                asm volatile("" ::: "memory"); }
    }
};
}

struct Ctx {
    typedef const float* const __attribute__((address_space(4)))* KAP;
    KAP ka; GAS unsigned char* ws; GAS float* outg; int layer; int G, bid;
    __device__ __forceinline__ const float* in(int i) const { return (const float*)(const GAS float*)ka[i]; }
    template <class T> __device__ __forceinline__ T* w(size_t off) const { return (T*)(GAS T*)(ws + off); }
    __device__ __forceinline__ float* out() const { return (float*)outg; }
    __device__ __forceinline__ void refresh() {
        KAP k = (KAP)__builtin_amdgcn_kernarg_segment_ptr(); asm volatile("" : "+s"(k)); ka = k;
        ws = (GAS unsigned char*)k[32]; outg = (GAS float*)k[31]; bid = lsg(blockIdx.x); G = lsg(gridDim.x); }
};

__device__ __forceinline__ int zsrc_col(int n) {
    if (n < 256) return 256 + n;
    if (n < 512) return 784 + (n - 256);
    if (n < 768) return 1552 + (n - 512);
    if (n < 1024) return 2576 + (n - 768);
    if (n < 1152) return n - 1024;
    if (n < 1280) return 128 + (n - 1152);
    if (n < 1536) return 528 + (n - 1280);
    if (n < 1792) return 1040 + (n - 1536);
    if (n < 2048) return 1296 + (n - 1792);
    if (n < 2304) return 1808 + (n - 2048);
    if (n < 2560) return 2064 + (n - 2304);
    if (n < 2816) return 2320 + (n - 2560);
    return 2840 + (n - 2816);
}
__device__ __forceinline__ void convT_tile(float* sm, const float* src, int pitch, int src_col0, int k0, const float* gain, bf16_t* dst, int dst_row0, int dstK, int tid) {
#pragma unroll
    for (int i = 0; i < 2; ++i) { const int kk = (tid >> 4) + 32 * i, c4 = (tid & 15) * 4;
        const f32x4 v = *(const f32x4*)(src + (size_t)(k0 + kk) * pitch + src_col0 + c4); const float g = gain ? gain[k0 + kk] : 1.f;
        float* d = sm + kk * 65 + c4; d[0] = v[0] * g; d[1] = v[1] * g; d[2] = v[2] * g; d[3] = v[3] * g; }
    __syncthreads();
    { const int n = tid >> 3, k8 = (tid & 7) * 8; float v[8];
#pragma unroll
      for (int j = 0; j < 8; ++j) v[j] = sm[(k8 + j) * 65 + n];
      *(u32x4*)(dst + (size_t)(dst_row0 + n) * dstK + k0 + k8) = pack8(v); }
    __syncthreads();
}
constexpr int CT_IN = 48 * 16, CT_OUT = 256, CT_GLU = 16, CT_EARLY = CT_IN + CT_OUT + CT_GLU, CT_ALL = CT_EARLY + 88 * 16 + 16 * 44 + 256 + 64;
static __device__ __forceinline__ void phase_conv(const Ctx& c, float* sm, const int l, const int wid, const int nw, const int t_lo, const int t_hi, const bool do_small) {
    const int tid = ltid();
    const float* w_in = c.in(I_WIN) + (size_t)l * DM * INW; const float* g_mix = c.in(I_NMIX) + l * DM;
    const float* w_out = c.in(I_WOUT) + (size_t)l * DM * DM;
    const float* w_up = c.in(I_WUP) + (size_t)l * DM * NUP; const float* g_ffn = c.in(I_NFFN) + l * DM;
    const float* w_dn = c.in(I_WDN) + (size_t)l * FF * DM;
    const float* w_pg = c.in(I_WPG) + (size_t)l * DM * DM; const float* g_ple = c.in(I_NPLE) + l * DM;
    const float* w_pp = c.in(I_WPP) + (size_t)l * PLED * DM;
    const float* w_glu = c.in(I_S5_WGLU) + (size_t)l * 256 * 256;
    constexpr int T_IN = 48 * 16, T_OUT = 256, T_UP = 88 * 16, T_DN = 16 * 44, T_PG = 256, T_PP = 64, T_GLU = 16;
    constexpr int T_ALL = T_IN + T_OUT + T_UP + T_DN + T_PG + T_PP + T_GLU;
    struct TD { const float* src; const float* gain; bf16_t* dst; int pitch, sc, k0, row0, dstK; };
    auto desc = [&](int t) -> TD {
        int u = t;
        if (u < T_IN) { const int nt = u >> 4, kt = u & 15; return TD{w_in, g_mix, c.w<bf16_t>(WS_WIN), INW, zsrc_col(nt * 64), kt * 64, nt * 64, DM}; }
        u -= T_IN;
        if (u < T_OUT) { const int nt = u >> 4, kt = u & 15; return TD{w_out, nullptr, c.w<bf16_t>(WS_WOUT), DM, nt * 64, kt * 64, nt * 64, DM}; }
        u -= T_OUT;
        if (u < T_GLU) { const int nt = u >> 2, kt = u & 3; return TD{w_glu, nullptr, c.w<bf16_t>(WS_WGLU), 256, nt * 64, kt * 64, nt * 64, 256}; }
        u -= T_GLU;
        if (u < T_UP) { const int nt = u >> 4, kt = u & 15; const int n0 = nt * 64, pn = n0 >> 8, r = n0 & 255; const int sc = (r < 128) ? (128 * pn + r) : (FF + 128 * pn + (r - 128));
            return TD{w_up, g_ffn, c.w<bf16_t>(WS_WUP), NUP, sc, kt * 64, n0, DM}; }
        u -= T_UP;
        if (u < T_DN) { const int nt = u / 44, kt = u % 44; return TD{w_dn, nullptr, c.w<bf16_t>(WS_WDN), DM, nt * 64, kt * 64, nt * 64, FF}; }
        u -= T_DN;
        if (u < T_PG) { const int nt = u >> 4, kt = u & 15; return TD{w_pg, g_ple, c.w<bf16_t>(WS_WPG), DM, nt * 64, kt * 64, nt * 64, DM}; }
        u -= T_PG;
        { const int nt = u >> 2, kt = u & 3; return TD{w_pp, nullptr, c.w<bf16_t>(WS_WPP), DM, nt * 64, kt * 64, nt * 64, PLED}; }
    };
    static_assert(T_ALL == CT_ALL && T_IN + T_OUT + T_GLU == CT_EARLY, "tile ranges");
    for (int t0 = t_lo + wid; t0 < t_hi; t0 += 4 * nw) {
        f32x4 v[4][2];
#pragma unroll
        for (int u = 0; u < 4; ++u) { const int t = t0 + u * nw;
            if (t < t_hi) { const TD d = desc(t);
#pragma unroll
                for (int i = 0; i < 2; ++i) { const int kk = (tid >> 4) + 32 * i, c4 = (tid & 15) * 4;
                    const f32x4 x = __builtin_nontemporal_load((const f32x4*)(d.src + (size_t)(d.k0 + kk) * d.pitch + d.sc + c4)); const float g = d.gain ? d.gain[d.k0 + kk] : 1.f; v[u][i] = x * g; } }
            else { v[u][0] = (f32x4){0.f, 0.f, 0.f, 0.f}; v[u][1] = v[u][0]; } }
#pragma unroll
        for (int u = 0; u < 4; ++u)
#pragma unroll
            for (int i = 0; i < 2; ++i) { const int kk = (tid >> 4) + 32 * i, c4 = (tid & 15) * 4; float* dd = sm + u * 4160 + kk * 65 + c4; dd[0] = v[u][i][0]; dd[1] = v[u][i][1]; dd[2] = v[u][i][2]; dd[3] = v[u][i][3]; }
        __syncthreads();
#pragma unroll
        for (int u = 0; u < 4; ++u) { const int t = t0 + u * nw;
            if (t < t_hi) { const TD d = desc(t); const int n = tid >> 3, k8 = (tid & 7) * 8; float w[8];
#pragma unroll
                for (int j = 0; j < 8; ++j) w[j] = sm[u * 4160 + (k8 + j) * 65 + n];
                *(u32x4*)(d.dst + (size_t)(d.row0 + n) * d.dstK + d.k0 + k8) = pack8(w); } }
        __syncthreads();
    }
    if (!do_small) return;
    const int gtid = wid * NTHR + tid, gsz = nw * NTHR;
    { bf16_t* ws_sm = c.w<bf16_t>(WS_WSM);
      for (int e = gtid; e < 32 * DM; e += gsz) { const int j = e >> 10, k = e & 1023; float v = 0.f;
          if (j < 24) { const int col = (j < 16) ? (512 + j) : (j < 20 ? 2832 + (j - 16) : 2836 + (j - 20)); v = g_mix[k] * w_in[(size_t)k * INW + col]; }
          ws_sm[e] = (bf16_t)f2bf(v); } }
    for (int e = gtid; e < 16 * 8 * 64; e += gsz) {
        const int g = e >> 9, ct = (e >> 6) & 7, ln = e & 63; const int n = ln & 15, q = ln >> 4; const int pp = 16 * ct + n; const int p = pp & 63; const bool im = pp >= 64; const int gp = g * 64 + p;
        const float lre = fminf(c.in(I_S5_LRE)[l * 1024 + gp], -1e-4f), lim = c.in(I_S5_LIM)[l * 1024 + gp];
        const float dt = __expf(c.in(I_S5_LOGDT)[l * 16 + g]);
        const double x = (double)lre * (double)dt, y = (double)lim * (double)dt;
        float s1, c1; sincos_d(y, s1, c1);
        const float m1 = __expf((float)x);
        const float ar = m1 * c1, ai = m1 * s1;
        if (ct < 4 && q == 0) { float s64, c64; sincos_d(64.0 * y, s64, c64); const float m64 = __expf((float)(64.0 * x));
            float* A = c.w<float>(WS_S5A); A[gp] = ar; A[1024 + gp] = ai; A[2048 + gp] = m64 * c64; A[3072 + gp] = m64 * s64; }
        const float nr = ar - 1.f, ni = ai, den = 1.f / (lre * lre + lim * lim);
        const float cr = (nr * lre + ni * lim) * den, ci = (ni * lre - nr * lim) * den;
        const float* bre = c.in(I_S5_BRE) + (size_t)l * 16384 + (size_t)gp * 16 + 8 * (q & 1); const float* bim = c.in(I_S5_BIM) + (size_t)l * 16384 + (size_t)gp * 16 + 8 * (q & 1);
        float v[8];
#pragma unroll
        for (int j = 0; j < 8; ++j) { const float br = bre[j], bi = bim[j]; const float val = im ? (cr * bi + ci * br) : (cr * br - ci * bi);
            const float hi = __builtin_bit_cast(float, f2bf(val) << 16); v[j] = (q < 2) ? hi : (val - hi); }
        *(u32x4*)(c.w<bf16_t>(WS_S5BB) + (size_t)e * 8) = pack8(v);
    }
    if (l == 0) {
        float* rowss = c.w<float>(WS_ROWSS); bf16_t* hb = c.w<bf16_t>(WS_HB); const float* x = c.in(I_X);
        for (int e = gtid; e < 6 * MTOK; e += gsz) ((u64_t*)rowss)[MTOK + e] = 0u;
        const int lane = tid & 63, gw = wid * 8 + (tid >> 6), nwv = nw * 8;
        for (int row = gw; row < MTOK; row += nwv) { float ss = 0.f;
#pragma unroll
            for (int i = 0; i < 4; ++i) { const f32x4 v = __builtin_nontemporal_load((const f32x4*)(x + (size_t)row * DM + i * 256 + lane * 4)); ss += (v[0] * v[0] + v[1] * v[1]) + (v[2] * v[2] + v[3] * v[3]);
                u32x2 w; w.x = pk2(v[0], v[1]); w.y = pk2(v[2], v[3]); *(u32x2*)(hb + (size_t)row * DM + i * 256 + lane * 4) = w; }
#pragma unroll
            for (int o = 32; o > 0; o >>= 1) ss += __shfl_xor(ss, o);
            if (lane == 0) ((u64_t*)rowss)[row] = (u64_t)(ss * SS_SCALE + 0.5f); }
    }
}

static __device__ __forceinline__ void small_proj(const Ctx& c, const bf16_t* hb, const float* rowss) {
    const int tid = ltid(), lane = tid & 63, i = lane & 15, q = lane >> 4;
    const bf16_t* wsm = c.w<bf16_t>(WS_WSM); float* zs = c.w<float>(WS_ZS);
    for (int wt = c.bid * 8 + (tid >> 6); wt < MTOK / 16; wt += c.G * 8) {
        const bf16_t* ap = hb + (size_t)(wt * 16 + i) * DM + 8 * q; const bf16_t* b0 = wsm + (size_t)i * DM + 8 * q; const bf16_t* b1 = wsm + (size_t)(16 + i) * DM + 8 * q;
        f32x4 a0 = {0.f, 0.f, 0.f, 0.f}, a1 = {0.f, 0.f, 0.f, 0.f};
#pragma unroll 8
        for (int k = 0; k < DM; k += 32) { const bf16x8 av = *(const bf16x8*)(ap + k), bv0 = *(const bf16x8*)(b0 + k), bv1 = *(const bf16x8*)(b1 + k);
            a0 = __builtin_amdgcn_mfma_f32_16x16x32_bf16(av, bv0, a0, 0, 0, 0); a1 = __builtin_amdgcn_mfma_f32_16x16x32_bf16(av, bv1, a1, 0, 0, 0); }
#pragma unroll
        for (int r = 0; r < 4; ++r) { const int row = wt * 16 + 4 * q + r; const float rs = row_rs(rowss, row);
            zs[(size_t)row * 32 + i] = a0[r] * rs; zs[(size_t)row * 32 + 16 + i] = a1[r] * rs; }
    }
}

static __device__ __forceinline__ void gdn_m1(const Ctx& c, float* sm, int item) {
    const int tid = ltid(), lane = tid & 63, wv = tid >> 6, l = c.layer;
    const int n = item & 31, h = (item >> 5) & 3, b = item >> 7; const int tok0 = b * SEQL + n * 64;
    float* Q = sm; float* Kk = sm + 4352; float* V = sm + 8704; float* AM = sm + 13056; float* QK = sm + 17408; float* X = sm + 21760; float* beta = sm + 30208; float* gc = beta + 64;
    const bf16_t* z = c.w<bf16_t>(WS_Z); const float* zs = c.w<float>(WS_ZS);
    if (tid < 64) {
        const float* zr = zs + (size_t)(tok0 + tid) * 32; const float db = zr[16 + h], da = zr[20 + h];
        float g = -__expf(c.in(I_GDN_ALOG)[l * 4 + h]) * softplusf(da + c.in(I_GDN_DTB)[l * 4 + h]);
#pragma unroll
        for (int o = 1; o < 64; o <<= 1) { const float t = __shfl_up(g, o); if (lane >= o) g += t; }
        beta[tid] = sigm(db); gc[tid] = g;
    }
    {
        float* RAW = AM;
        u32x4 rw[4];
#pragma unroll
        for (int i = 0; i < 4; ++i) { const int idx = tid + i * NTHR; rw[i] = (u32x4){0u, 0u, 0u, 0u};
            if (idx < 3 * 536) { const int part = idx / 536, rem = idx - part * 536; const int rr = rem >> 3, c8 = (rem & 7) * 8;
                const int zcol = (part == 0 ? ZC_DQ : (part == 1 ? ZC_DK : ZC_DV)) + h * 64;
                if (!(n == 0 && rr < 3)) rw[i] = *(const u32x4*)(z + (size_t)(tok0 - 3 + rr) * NZ + zcol + c8); } }
        const int r = tid >> 3, c8 = (tid & 7) * 8;
        f32x4 cwv[3][4][2];
#pragma unroll
        for (int part = 0; part < 3; ++part) { const float* cw = c.in(I_GDN_CONV) + (size_t)l * 4 * 768 + part * 256 + h * 64 + c8;
#pragma unroll
            for (int t = 0; t < 4; ++t) { cwv[part][t][0] = *(const f32x4*)(cw + t * 768); cwv[part][t][1] = *(const f32x4*)(cw + t * 768 + 4); } }
#pragma unroll
        for (int i = 0; i < 4; ++i) { const int idx = tid + i * NTHR;
            if (idx < 3 * 536) { const int part = idx / 536, rem = idx - part * 536; const int rr = rem >> 3, cc = (rem & 7) * 8; float v[8]; unpack8(rw[i], v);
                float* d = RAW + part * 4560 + rr * 68 + cc; *(f32x4*)d = (f32x4){v[0], v[1], v[2], v[3]}; *(f32x4*)(d + 4) = (f32x4){v[4], v[5], v[6], v[7]}; } }
        LBAR();
        f32x4 o[3][2];
#pragma unroll
        for (int part = 0; part < 3; ++part) { f32x4 a0 = {0.f, 0.f, 0.f, 0.f}, a1 = {0.f, 0.f, 0.f, 0.f};
#pragma unroll
            for (int t = 0; t < 4; ++t) { const float* raw = RAW + part * 4560 + (r + t) * 68 + c8; a0 += cwv[part][t][0] * *(const f32x4*)raw; a1 += cwv[part][t][1] * *(const f32x4*)(raw + 4); }
#pragma unroll
            for (int j = 0; j < 4; ++j) { a0[j] = siluf(a0[j]); a1[j] = siluf(a1[j]); }
            o[part][0] = a0; o[part][1] = a1; }
#pragma unroll
        for (int part = 0; part < 3; ++part) { float* dst = (part == 0 ? Q : (part == 1 ? Kk : V)) + r * 68 + c8; *(f32x4*)dst = o[part][0]; *(f32x4*)(dst + 4) = o[part][1]; }
        LBAR();
    }
    { const int r = tid >> 3, c8 = (tid & 7) * 8;
#pragma unroll
      for (int mt = 0; mt < 2; ++mt) { float* p = (mt ? Kk : Q) + r * 68 + c8; const f32x4 u0 = *(const f32x4*)p, u1 = *(const f32x4*)(p + 4);
          float ss = ((u0[0] * u0[0] + u0[1] * u0[1]) + (u0[2] * u0[2] + u0[3] * u0[3])) + ((u1[0] * u1[0] + u1[1] * u1[1]) + (u1[2] * u1[2] + u1[3] * u1[3]));
          ss += __shfl_xor(ss, 1); ss += __shfl_xor(ss, 2); ss += __shfl_xor(ss, 4);
          const float sc = rsqrtf(ss + EPSF) * (mt ? 1.f : 0.125f);
          *(f32x4*)p = u0 * sc; *(f32x4*)(p + 4) = u1 * sc; } }
    LBAR();
    for (int job = wv; job < 20; job += 8) {
        const int which = job >= 10, p = job - which * 10; const int ti = (p >= 6) ? 3 : ((p >= 3) ? 2 : ((p >= 1) ? 1 : 0)), tj = p - ti * (ti + 1) / 2; float* dstm = which ? QK : AM;
        f32x4 acc = {0.f, 0.f, 0.f, 0.f};
        acc = mm16v<true>((which ? Q : Kk) + ti * 16 * 68, 68, Kk + tj * 16 * 68, 68, 64, acc, lane);
#pragma unroll
        for (int r = 0; r < 4; ++r) { const int i = ti * 16 + 4 * (lane >> 4) + r, j = tj * 16 + (lane & 15);
            const float dec = (i >= j) ? __expf(gc[i] - gc[j]) : 0.f;
            float v = acc[r] * dec; if (!which) v = (i > j) ? v * beta[i] : 0.f;
            dstm[i * 68 + j] = v; }
    }
    for (int e = tid; e < 1024; e += NTHR) { const int i = e >> 4, j = (e & 15) * 4; if ((j >> 4) > (i >> 4)) *(f32x4*)(QK + i * 68 + j) = (f32x4){0.f, 0.f, 0.f, 0.f}; }
    for (int e = tid; e < 64 * 32; e += NTHR) { const int i = e >> 5, c4 = (e & 31) * 4; const float bi = beta[i];
        const f32x4 src = (c4 < 64) ? *(const f32x4*)(V + i * 68 + c4) : *(const f32x4*)(Kk + i * 68 + c4 - 64); const float f = (c4 < 64) ? bi : bi * __expf(gc[i]);
        *(f32x4*)(X + i * 132 + c4) = src * f; }
    LBAR();
    if (wv < 4) {
        const int I = wv, li = lane & 15, lq = lane >> 4; const float* Nm = AM + (I * 16) * 68 + I * 16;
        float* INV = V + I * 272; float* T0 = V + 1088 + wv * 816; float* T1 = T0 + 272; float* T2 = T1 + 272; const f32x4 zero4 = {0.f, 0.f, 0.f, 0.f};
#define WR_T(T, v) do { _Pragma("unroll") for (int r = 0; r < 4; ++r) (T)[(4 * lq + r) * 17 + li] = (v)[r]; } while (0)
#define WFENCE() asm volatile("s_waitcnt lgkmcnt(0)" ::: "memory")
        f32x4 p1;
#pragma unroll
        for (int r = 0; r < 4; ++r) p1[r] = ((4 * lq + r) == li ? 1.f : 0.f) - Nm[(4 * lq + r) * 68 + li];
        const f32x4 n2 = mm16(Nm, 68, 1, Nm, 68, 1, 16, zero4, lane);
        WR_T(T0, n2); WR_T(T1, p1); WFENCE();
        const f32x4 p2 = mm16(T1, 17, 1, T0, 17, 1, 16, p1, lane);
        const f32x4 n4 = mm16(T0, 17, 1, T0, 17, 1, 16, zero4, lane);
        WFENCE(); WR_T(T1, p2); WR_T(T2, n4); WFENCE();
        const f32x4 p3 = mm16(T1, 17, 1, T2, 17, 1, 16, p2, lane);
        const f32x4 n8 = mm16(T2, 17, 1, T2, 17, 1, 16, zero4, lane);
        WFENCE(); WR_T(T1, p3); WR_T(T0, n8); WFENCE();
        const f32x4 p4 = mm16(T1, 17, 1, T0, 17, 1, 16, p3, lane);
        WR_T(INV, p4);
    }
    LBAR();
    { const int li = lane & 15, lq = lane >> 4;
#pragma unroll 1
      for (int I = 0; I < 4; ++I) { float* Xt = X + (I * 16) * 132 + wv * 16;
          if (I > 0) { f32x4 acc = {0.f, 0.f, 0.f, 0.f}; acc = mm16v<false>(AM + I * 16 * 68, 68, X + wv * 16, 132, 16 * I, acc, lane);
#pragma unroll
              for (int r = 0; r < 4; ++r) Xt[(4 * lq + r) * 132 + li] -= acc[r];
              WFENCE(); }
          f32x4 xs = {0.f, 0.f, 0.f, 0.f}; xs = mm16(V + I * 272, 17, 1, Xt, 132, 1, 16, xs, lane);
          WFENCE();
#pragma unroll
          for (int r = 0; r < 4; ++r) Xt[(4 * lq + r) * 132 + li] = xs[r];
          WFENCE(); } }
#undef WR_T
#undef WFENCE
    LBAR();
    { const int r = tid >> 3, c8 = (tid & 7) * 8; const size_t o = (size_t)item * 4096 + r * 64 + c8;
      float* U = c.w<float>(WS_GU) + o; float* W = c.w<float>(WS_GW) + o; float* A = c.w<float>(WS_GA) + o;
      *(f32x4*)U = *(const f32x4*)(X + r * 132 + c8); *(f32x4*)(U + 4) = *(const f32x4*)(X + r * 132 + c8 + 4);
      *(f32x4*)W = *(const f32x4*)(X + r * 132 + 64 + c8); *(f32x4*)(W + 4) = *(const f32x4*)(X + r * 132 + 64 + c8 + 4);
      *(f32x4*)A = *(const f32x4*)(QK + r * 68 + c8); *(f32x4*)(A + 4) = *(const f32x4*)(QK + r * 68 + c8 + 4);
      const float eg = __expf(gc[r]); float qd[8], ke[8];
#pragma unroll
      for (int j = 0; j < 8; ++j) { qd[j] = ((j < 4) ? (*(const f32x4*)(Q + r * 68 + c8))[j & 3] : (*(const f32x4*)(Q + r * 68 + c8 + 4))[j & 3]) * eg; ke[j] = Kk[(c8 + j) * 68 + r] * __expf(gc[63] - gc[c8 + j]); }
      *(u32x4*)(c.w<bf16_t>(WS_GQD) + o) = pack8(qd); *(u32x4*)(c.w<bf16_t>(WS_GKE) + o) = pack8(ke);
      if (tid == 0) c.w<float>(WS_GDL)[item] = __expf(gc[63]); }
    LBAR();
}

static __device__ __forceinline__ void gdn_m2(const Ctx& c, float* sm, int item) {
    const int tid = ltid(), lane = tid & 63, wv = tid >> 6;
    const int sl = item & 3, bh = item >> 2;
    float* S = sm; float* VN = sm + 1152;
    for (int e = tid; e < 1152; e += NTHR) S[e] = 0.f;
    const int ti = wv & 3, i = lane & 15, q = lane >> 4, row = ti * 16 + i;
    const float* GDL = c.w<float>(WS_GDL) + bh * 32;
    LBAR();
    if (wv < 4) {
        struct PA { f32x4 w[4]; u32x4 k[2]; float u[4]; float dl; };
        PA P0, P1, P2, P3;
        const float* Wb = c.w<float>(WS_GW) + (size_t)bh * 32 * 4096 + row * 64 + 16 * q;
        const bf16_t* Kb = c.w<bf16_t>(WS_GKE) + (size_t)bh * 32 * 4096 + row * 64 + 16 * q;
        const float* Ub = c.w<float>(WS_GU) + (size_t)bh * 32 * 4096 + (ti * 16 + 4 * q) * 64 + sl * 16 + i;
#define LOAD_A(P, nn) do { const int n_ = ((nn) < NCH) ? (nn) : NCH - 1; const float* Wp = Wb + (size_t)n_ * 4096; const bf16_t* Kp = Kb + (size_t)n_ * 4096; const float* Up = Ub + (size_t)n_ * 4096; \
        P.w[0] = *(const f32x4*)Wp; P.w[1] = *(const f32x4*)(Wp + 4); P.w[2] = *(const f32x4*)(Wp + 8); P.w[3] = *(const f32x4*)(Wp + 12); \
        P.k[0] = *(const u32x4*)Kp; P.k[1] = *(const u32x4*)(Kp + 8); P.u[0] = Up[0]; P.u[1] = Up[64]; P.u[2] = Up[128]; P.u[3] = Up[192]; P.dl = GDL[n_]; } while (0)
#define STEP_A(P, PN, n) do { LOAD_A(PN, (n) + 3); \
        f32x4 a0 = {0.f, 0.f, 0.f, 0.f}, a1 = {0.f, 0.f, 0.f, 0.f}; \
        { const f32x4 s0_ = *(const f32x4*)(S + i * 68 + 16 * q), s1_ = *(const f32x4*)(S + i * 68 + 16 * q + 4), s2_ = *(const f32x4*)(S + i * 68 + 16 * q + 8), s3_ = *(const f32x4*)(S + i * 68 + 16 * q + 12); \
        _Pragma("unroll") for (int e = 0; e < 4; ++e) { a0 = __builtin_amdgcn_mfma_f32_16x16x4f32(P.w[0][e], s0_[e], a0, 0, 0, 0); a1 = __builtin_amdgcn_mfma_f32_16x16x4f32(P.w[2][e], s2_[e], a1, 0, 0, 0); } \
        _Pragma("unroll") for (int e = 0; e < 4; ++e) { a0 = __builtin_amdgcn_mfma_f32_16x16x4f32(P.w[1][e], s1_[e], a0, 0, 0, 0); a1 = __builtin_amdgcn_mfma_f32_16x16x4f32(P.w[3][e], s3_[e], a1, 0, 0, 0); } } \
        a0 += a1; \
        { f32x4 vn_; _Pragma("unroll") for (int r = 0; r < 4; ++r) vn_[r] = P.u[r] - a0[r]; *(f32x4*)(VN + i * 68 + ti * 16 + 4 * q) = vn_; } \
        LBAR(); \
        float kt[16]; unpack8(P.k[0], kt); unpack8(P.k[1], kt + 8); \
        f32x4 b0 = {0.f, 0.f, 0.f, 0.f}, b1 = {0.f, 0.f, 0.f, 0.f}; \
        { const f32x4 v0_ = *(const f32x4*)(VN + i * 68 + 16 * q), v1_ = *(const f32x4*)(VN + i * 68 + 16 * q + 4), v2_ = *(const f32x4*)(VN + i * 68 + 16 * q + 8), v3_ = *(const f32x4*)(VN + i * 68 + 16 * q + 12); \
        _Pragma("unroll") for (int e = 0; e < 4; ++e) { b0 = __builtin_amdgcn_mfma_f32_16x16x4f32(kt[e], v0_[e], b0, 0, 0, 0); b1 = __builtin_amdgcn_mfma_f32_16x16x4f32(kt[8 + e], v2_[e], b1, 0, 0, 0); } \
        _Pragma("unroll") for (int e = 0; e < 4; ++e) { b0 = __builtin_amdgcn_mfma_f32_16x16x4f32(kt[4 + e], v1_[e], b0, 0, 0, 0); b1 = __builtin_amdgcn_mfma_f32_16x16x4f32(kt[12 + e], v3_[e], b1, 0, 0, 0); } } \
        b0 += b1; \
        { float* sp_ = S + i * 68 + ti * 16 + 4 * q; const f32x4 so_ = *(const f32x4*)sp_; *(f32x4*)sp_ = so_ * P.dl + b0; } \
        LBAR(); } while (0)
        LOAD_A(P0, 0); LOAD_A(P1, 1); LOAD_A(P2, 2);
#pragma unroll 1
        for (int n = 0; n < NCH; n += 4) { STEP_A(P0, P3, n); STEP_A(P1, P0, n + 1); STEP_A(P2, P1, n + 2); STEP_A(P3, P2, n + 3); }
#undef STEP_A
#undef LOAD_A
    } else {
        struct PB { u32x4 qd[2]; f32x4 a[4]; };
        PB P0, P1, P2, P3;
        const bf16_t* Qb = c.w<bf16_t>(WS_GQD) + (size_t)bh * 32 * 4096 + row * 64 + 16 * q;
        const float* Ab = c.w<float>(WS_GA) + (size_t)bh * 32 * 4096 + row * 64 + 16 * q;
        float* Ob = c.w<float>(WS_GU) + (size_t)bh * 32 * 4096 + (ti * 16 + 4 * q) * 64 + sl * 16 + i;
#define LOAD_B(P, nn) do { const int n_ = ((nn) < NCH) ? (nn) : NCH - 1; const bf16_t* Qp = Qb + (size_t)n_ * 4096; const float* Ap = Ab + (size_t)n_ * 4096; \
        P.qd[0] = *(const u32x4*)Qp; P.qd[1] = *(const u32x4*)(Qp + 8); P.a[0] = *(const f32x4*)Ap; P.a[1] = *(const f32x4*)(Ap + 4); P.a[2] = *(const f32x4*)(Ap + 8); P.a[3] = *(const f32x4*)(Ap + 12); } while (0)
#define STEP_B(P, PN, n) do { LOAD_B(PN, (n) + 3); \
        float qt[16]; unpack8(P.qd[0], qt); unpack8(P.qd[1], qt + 8); \
        f32x4 a0 = {0.f, 0.f, 0.f, 0.f}, a1 = {0.f, 0.f, 0.f, 0.f}; \
        { const f32x4 s0_ = *(const f32x4*)(S + i * 68 + 16 * q), s1_ = *(const f32x4*)(S + i * 68 + 16 * q + 4), s2_ = *(const f32x4*)(S + i * 68 + 16 * q + 8), s3_ = *(const f32x4*)(S + i * 68 + 16 * q + 12); \
        _Pragma("unroll") for (int e = 0; e < 4; ++e) { a0 = __builtin_amdgcn_mfma_f32_16x16x4f32(qt[e], s0_[e], a0, 0, 0, 0); a1 = __builtin_amdgcn_mfma_f32_16x16x4f32(qt[8 + e], s2_[e], a1, 0, 0, 0); } \
        _Pragma("unroll") for (int e = 0; e < 4; ++e) { a0 = __builtin_amdgcn_mfma_f32_16x16x4f32(qt[4 + e], s1_[e], a0, 0, 0, 0); a1 = __builtin_amdgcn_mfma_f32_16x16x4f32(qt[12 + e], s3_[e], a1, 0, 0, 0); } } \
        LBAR(); \
        { const f32x4 v0_ = *(const f32x4*)(VN + i * 68 + 16 * q), v1_ = *(const f32x4*)(VN + i * 68 + 16 * q + 4), v2_ = *(const f32x4*)(VN + i * 68 + 16 * q + 8), v3_ = *(const f32x4*)(VN + i * 68 + 16 * q + 12); \
        _Pragma("unroll") for (int e = 0; e < 4; ++e) { a0 = __builtin_amdgcn_mfma_f32_16x16x4f32(P.a[0][e], v0_[e], a0, 0, 0, 0); a1 = __builtin_amdgcn_mfma_f32_16x16x4f32(P.a[2][e], v2_[e], a1, 0, 0, 0); } \
        _Pragma("unroll") for (int e = 0; e < 4; ++e) { a0 = __builtin_amdgcn_mfma_f32_16x16x4f32(P.a[1][e], v1_[e], a0, 0, 0, 0); a1 = __builtin_amdgcn_mfma_f32_16x16x4f32(P.a[3][e], v3_[e], a1, 0, 0, 0); } } \
        a0 += a1; \
        { float* Op = Ob + (size_t)(n) * 4096; Op[0] = a0[0]; Op[64] = a0[1]; Op[128] = a0[2]; Op[192] = a0[3]; } \
        LBAR(); } while (0)
        LOAD_B(P0, 0); LOAD_B(P1, 1); LOAD_B(P2, 2);
#pragma unroll 1
        for (int n = 0; n < NCH; n += 4) { STEP_B(P0, P3, n); STEP_B(P1, P0, n + 1); STEP_B(P2, P1, n + 2); STEP_B(P3, P2, n + 3); }
#undef STEP_B
#undef LOAD_B
    }
}
static __device__ __forceinline__ void gdn_m3(const Ctx& c, int item) {
    const int tid = ltid(), l = c.layer; const int n = item & 31, h = (item >> 5) & 3, b = item >> 7; const int tok0 = b * SEQL + n * 64;
    const int r = tid >> 3, c8 = (tid & 7) * 8;
    const float* O = c.w<float>(WS_GU) + (size_t)item * 4096 + r * 64 + c8; bf16_t* z = c.w<bf16_t>(WS_Z) + (size_t)(tok0 + r) * NZ;
    const f32x4 a = __builtin_nontemporal_load((const f32x4*)O), bq = __builtin_nontemporal_load((const f32x4*)(O + 4)); float v[8] = {a[0], a[1], a[2], a[3], bq[0], bq[1], bq[2], bq[3]};
    float ss = 0.f;
#pragma unroll
    for (int j = 0; j < 8; ++j) ss += v[j] * v[j];
    ss += __shfl_xor(ss, 1); ss += __shfl_xor(ss, 2); ss += __shfl_xor(ss, 4);
    const float rs = rsqrtf(ss * (1.f / 64.f) + EPSF); float gt[8]; unpack8(*(const u32x4*)(z + ZC_DG + h * 64 + c8), gt);
    const float* ng = c.in(I_GDN_NORM) + l * 64 + c8;
#pragma unroll
    for (int j = 0; j < 8; ++j) v[j] = v[j] * rs * ng[j] * siluf(gt[j]);
    *(u32x4*)(z + ZC_DV + h * 64 + c8) = pack8(v);
}

__device__ __forceinline__ float ret_loggamma(int h) { const float x = __builtin_bit_cast(float, (unsigned)(127 - 5 - h) << 23); return -x * (1.f + x * (0.5f + x * (0.33333334f + x * (0.25f + x * 0.2f)))); }
__device__ __forceinline__ void rope_tab(const Ctx& c, float* cs, float* sn, int tok0, int tid) {
    const int* pos = (const int*)c.in(I_POS);
    { const int s = tid >> 3, j4 = (tid & 7) * 4; const float pf = (float)pos[tok0 + s]; f32x4 cv, sv;
#pragma unroll
      for (int e = 0; e < 4; ++e) { const float invf = exp2f(-13.287712379549449f * (float)(j4 + e) * (1.f / 31.f)); float s1, c1; sincos_d((double)(pf * invf), s1, c1); cv[e] = c1; sv[e] = s1; }
      *(f32x4*)(cs + s * 32 + j4) = cv; *(f32x4*)(sn + s * 32 + j4) = sv; }
}
__device__ __forceinline__ void rope_apply(float* Mx, const float* cs, const float* sn, int tid, const float* rowscale  , float gs) {
    { const int s = tid >> 3, j4 = (tid & 7) * 4; const f32x4 x1 = *(const f32x4*)(Mx + s * 68 + j4), x2 = *(const f32x4*)(Mx + s * 68 + 32 + j4), cv = *(const f32x4*)(cs + s * 32 + j4), sv = *(const f32x4*)(sn + s * 32 + j4);
      const float f = gs * (rowscale ? rowscale[s] : 1.f);
      *(f32x4*)(Mx + s * 68 + j4) = (x1 * cv - x2 * sv) * f; *(f32x4*)(Mx + s * 68 + 32 + j4) = (x1 * sv + x2 * cv) * f; }
}
static __device__ __forceinline__ void ret_m1(const Ctx& c, float* sm, int item) {
    const int tid = ltid(), lane = tid & 63, wv = tid >> 6; const int n = item & 31, h = (item >> 5) & 3, b = item >> 7; const int tok0 = b * SEQL + n * 64;
    float* Kk = sm; float* V = sm + 4352; float* cs = sm + 8704; float* sn = cs + 2048; float* zeta = sn + 2048;
    const bf16_t* z = c.w<bf16_t>(WS_Z) + (size_t)tok0 * NZ;
    { const u32x4 rk = ldg_tile64(z + ZC_RK + h * 64, NZ, tid), rv = ldg_tile64(z + ZC_RV + h * 64, NZ, tid); st_tile64(Kk, rk, tid); st_tile64(V, rv, tid); }
    rope_tab(c, cs, sn, tok0, tid);
    const float lg = ret_loggamma(h);
    if (tid < 64) zeta[tid] = __expf((63.f - (float)tid) * lg);
    LBAR();
    rope_apply(Kk, cs, sn, tid, zeta, 0.125f);
    LBAR();
    float* DS = c.w<float>(WS_RDS) + (size_t)item * 4096;
    { const int ti = wv >> 1, cb = 32 * (wv & 1); f32x4 a0 = {0.f, 0.f, 0.f, 0.f}, a1 = a0;
      mm16t2(Kk + ti * 16, 68, V + cb, 68, 64, a0, a1, lane);
      float* dp = DS + (cb + 2 * (lane & 15)) * 64 + ti * 16 + 4 * (lane >> 4); *(f32x4*)dp = a0; *(f32x4*)(dp + 64) = a1; }
    LBAR();
}
static __device__ __forceinline__ void ret_m3(const Ctx& c, float* sm, int item) {
    const int tid = ltid(), lane = tid & 63, wv = tid >> 6, l = c.layer; const int n = item & 31, h = (item >> 5) & 3, b = item >> 7; const int tok0 = b * SEQL + n * 64;
    float* Q = sm; float* Kk = sm + 4352; float* V = sm + 8704; float* S = sm + 13056; float* Pm = sm + 17408; float* O = sm + 21760; float* cs = sm + 26112; float* sn = cs + 2048;
    bf16_t* z = c.w<bf16_t>(WS_Z) + (size_t)tok0 * NZ;
    { const u32x4 rq = ldg_tile64(z + ZC_RQ + h * 64, NZ, tid), rk = ldg_tile64(z + ZC_RK + h * 64, NZ, tid), rv = ldg_tile64(z + ZC_RV + h * 64, NZ, tid);
      const float* Sg = c.w<float>(WS_RDS) + (size_t)item * 4096 + (tid >> 3) * 64 + (tid & 7) * 8; const f32x4 s0 = *(const f32x4*)Sg, s1 = *(const f32x4*)(Sg + 4);
      st_tile64(Q, rq, tid); st_tile64(Kk, rk, tid); st_tile64(V, rv, tid); *(f32x4*)(S + (tid >> 3) * 68 + (tid & 7) * 8) = s0; *(f32x4*)(S + (tid >> 3) * 68 + (tid & 7) * 8 + 4) = s1; }
    rope_tab(c, cs, sn, tok0, tid);
    const float lg = ret_loggamma(h);
    LBAR();
    rope_apply(Q, cs, sn, tid, nullptr, 1.f); rope_apply(Kk, cs, sn, tid, nullptr, 0.125f);
    LBAR();
    { const int ti = wv >> 1, cb = 32 * (wv & 1), li = lane & 15, lq = lane >> 4;
      f32x4 p0 = {0.f, 0.f, 0.f, 0.f}, p1 = p0;
      if (cb <= ti * 16 + 15) mm16v2<true>(Q + ti * 16 * 68, 68, Kk + cb * 68, 68, 64, p0, p1, lane);
#pragma unroll
      for (int r = 0; r < 4; ++r) { const int i = ti * 16 + 4 * lq + r, j = cb + 2 * li; f32x2 pv;
          pv[0] = (i >= j) ? p0[r] * __expf((float)(i - j) * lg) : 0.f; pv[1] = (i >= j + 1) ? p1[r] * __expf((float)(i - j - 1) * lg) : 0.f;
          *(f32x2*)(Pm + i * 68 + j) = pv; }
      LBAR();
      f32x4 a0 = {0.f, 0.f, 0.f, 0.f}, a1 = a0, c0 = a0, c1 = a0;
      mm16v2<false>(Pm + ti * 16 * 68, 68, V + cb, 68, 16 * (ti + 1), a0, a1, lane);
      mm16v2<true>(Q + ti * 16 * 68, 68, S + cb * 68, 68, 64, c0, c1, lane);
#pragma unroll
      for (int r = 0; r < 4; ++r) { const int i = ti * 16 + 4 * lq + r, j = cb + 2 * li; const float xi = __expf((float)(i + 1) * lg);
          *(f32x2*)(O + i * 68 + j) = (f32x2){a0[r] + xi * c0[r], a1[r] + xi * c1[r]}; } }
    LBAR();
    { const int r = tid >> 3, c8 = (tid & 7) * 8; float v[8]; float s1 = 0.f;
#pragma unroll
      for (int j = 0; j < 8; ++j) { v[j] = ((j < 4) ? (*(const f32x4*)(O + r * 68 + c8))[j & 3] : (*(const f32x4*)(O + r * 68 + c8 + 4))[j & 3]); s1 += v[j]; }
      s1 += __shfl_xor(s1, 1); s1 += __shfl_xor(s1, 2); s1 += __shfl_xor(s1, 4);
      const float mean = s1 * (1.f / 64.f); float s2 = 0.f;
#pragma unroll
      for (int j = 0; j < 8; ++j) { v[j] -= mean; s2 += v[j] * v[j]; }
      s2 += __shfl_xor(s2, 1); s2 += __shfl_xor(s2, 2); s2 += __shfl_xor(s2, 4);
      const float rs = rsqrtf(s2 * (1.f / 64.f) + EPSF); float gt[8]; unpack8(*(const u32x4*)(z + (size_t)r * NZ + ZC_RG + h * 64 + c8), gt);
      const float* ng = c.in(I_RET_NORM) + l * 256 + h * 64 + c8;
#pragma unroll
      for (int j = 0; j < 8; ++j) v[j] = v[j] * rs * ng[j] * siluf(gt[j]);
      *(u32x4*)(z + (size_t)r * NZ + ZC_RV + h * 64 + c8) = pack8(v); }
    LBAR();
}

__device__ __forceinline__ void gla_gates(const Ctx& c, float* Gb, float* AL, float* Wa, float* ba, int tok0, int h, int tid) {
    const int l = c.layer; const float* zs = c.w<float>(WS_ZS);
    { const float a0 = zs[(size_t)(tok0 + (tid >> 4)) * 32 + (tid & 15)], a1 = zs[(size_t)(tok0 + 32 + (tid >> 4)) * 32 + (tid & 15)];
      const float w0 = c.in(I_GLA_WA2)[(size_t)l * 16 * 128 + (tid >> 5) * 128 + h * 32 + (tid & 31)]; const float b0 = c.in(I_GLA_BA)[l * 128 + h * 32 + (tid & 31)];
      AL[tid] = a0; AL[512 + tid] = a1; Wa[tid] = w0; if (tid < 32) ba[tid] = b0; }
    LBAR();
    { const int s = tid >> 3, d4 = (tid & 7) * 4; f32x4 a = *(const f32x4*)(ba + d4);
#pragma unroll
      for (int r4 = 0; r4 < 4; ++r4) { const f32x4 al = *(const f32x4*)(AL + s * 16 + 4 * r4);
#pragma unroll
          for (int e = 0; e < 4; ++e) a += *(const f32x4*)(Wa + (4 * r4 + e) * 32 + d4) * al[e]; }
#pragma unroll
      for (int j = 0; j < 4; ++j) Gb[s * 33 + d4 + j] = -softplusf(-a[j]) * (1.f / 16.f); }
    LBAR();
    { const int wv = tid >> 6, lane = tid & 63;
#pragma unroll
      for (int j = 0; j < 4; ++j) { const int d = wv * 4 + j; float v = Gb[lane * 33 + d];
#pragma unroll
          for (int o = 1; o < 64; o <<= 1) { const float t = __shfl_up(v, o); if (lane >= o) v += t; }
          Gb[lane * 33 + d] = v; } }
    LBAR();
}
__device__ __forceinline__ void ld_tile64x32(float* dst  , const bf16_t* src, int tid) {
    if (tid < 256) { const int r = tid >> 2, c8 = (tid & 3) * 8; float v[8]; unpack8(*(const u32x4*)(src + (size_t)r * NZ + c8), v);
        float* d = dst + r * 36 + c8; *(f32x4*)d = (f32x4){v[0], v[1], v[2], v[3]}; *(f32x4*)(d + 4) = (f32x4){v[4], v[5], v[6], v[7]}; }
}
static __device__ __forceinline__ void gla_m1(const Ctx& c, float* sm, int item) {
    const int tid = ltid(), lane = tid & 63, wv = tid >> 6; const int n = item & 31, h = (item >> 5) & 3, b = item >> 7; const int tok0 = b * SEQL + n * 64;
    float* Kk = sm; float* V = sm + 2304; float* Gb = sm + 6656; float* AL = sm + 8768; float* Wa = AL + 1024; float* ba = Wa + 512;
    const bf16_t* z = c.w<bf16_t>(WS_Z) + (size_t)tok0 * NZ;
    { const u32x4 rk = ldg_tile64x32(z + ZC_AK + h * 32, tid), rv = ldg_tile64(z + ZC_AV + h * 64, NZ, tid); st_tile64x32(Kk, rk, tid); st_tile64(V, rv, tid); }
    gla_gates(c, Gb, AL, Wa, ba, tok0, h, tid);
    { const int s = tid >> 3, d4 = (tid & 7) * 4; f32x4 kv = *(const f32x4*)(Kk + s * 36 + d4);
#pragma unroll
      for (int j = 0; j < 4; ++j) kv[j] *= __expf(Gb[63 * 33 + d4 + j] - Gb[s * 33 + d4 + j]);
      *(f32x4*)(Kk + s * 36 + d4) = kv; }
    LBAR();
    { const int ti = wv >> 2, tj = wv & 3; f32x4 acc = {0.f, 0.f, 0.f, 0.f};
      acc = mm16(Kk + ti * 16, 1, 36, V + tj * 16, 68, 1, 64, acc, lane);
      float* DS = c.w<float>(WS_ADS) + (size_t)item * 2048;
      *(f32x4*)(DS + (tj * 16 + (lane & 15)) * 32 + ti * 16 + 4 * (lane >> 4)) = acc; }
    if (tid < 32) c.w<float>(WS_GLDEC)[item * 32 + tid] = __expf(Gb[63 * 33 + tid]);
    LBAR();
}
static __device__ __forceinline__ void gla_m3(const Ctx& c, float* sm, int item) {
    const int tid = ltid(), lane = tid & 63, wv = tid >> 6, l = c.layer; const int n = item & 31, h = (item >> 5) & 3, b = item >> 7; const int tok0 = b * SEQL + n * 64;
    float* Q = sm; float* Kk = sm + 2304; float* V = sm + 4608; float* S = sm + 8960  ; float* Pm = sm + 11264; float* O = sm + 15616; float* Gb = sm + 19968; float* AL = sm + 22080; float* Wa = AL + 1024; float* ba = Wa + 512;
    bf16_t* z = c.w<bf16_t>(WS_Z) + (size_t)tok0 * NZ;
    { const u32x4 rq = ldg_tile64x32(z + ZC_AQ + h * 32, tid), rk = ldg_tile64x32(z + ZC_AK + h * 32, tid), rv = ldg_tile64(z + ZC_AV + h * 64, NZ, tid);
      const float* Sg = c.w<float>(WS_ADS) + (size_t)item * 2048; const int r = tid >> 3, c4 = (tid & 7) * 4; const f32x4 s0 = *(const f32x4*)(Sg + r * 32 + c4);
      st_tile64x32(Q, rq, tid); st_tile64x32(Kk, rk, tid); st_tile64(V, rv, tid); *(f32x4*)(S + r * 36 + c4) = s0; }
    gla_gates(c, Gb, AL, Wa, ba, tok0, h, tid);
    { const int s = tid >> 3, d4 = (tid & 7) * 4; f32x4 qv = *(const f32x4*)(Q + s * 36 + d4), kv = *(const f32x4*)(Kk + s * 36 + d4);
#pragma unroll
      for (int j = 0; j < 4; ++j) { const float bb = Gb[s * 33 + d4 + j]; qv[j] *= __expf(bb) * 0.17677669529663687f; kv[j] *= __expf(-bb); }
      *(f32x4*)(Q + s * 36 + d4) = qv; *(f32x4*)(Kk + s * 36 + d4) = kv; }
    LBAR();
    { const int ti = wv >> 1, cb = 32 * (wv & 1), li = lane & 15, lq = lane >> 4;
      f32x4 p0 = {0.f, 0.f, 0.f, 0.f}, p1 = p0;
      if (cb <= ti * 16 + 15) mm16v2<true>(Q + ti * 16 * 36, 36, Kk + cb * 36, 36, 32, p0, p1, lane);
#pragma unroll
      for (int r = 0; r < 4; ++r) { const int i = ti * 16 + 4 * lq + r, j = cb + 2 * li;
          *(f32x2*)(Pm + i * 68 + j) = (f32x2){(i >= j) ? p0[r] : 0.f, (i >= j + 1) ? p1[r] : 0.f}; }
      LBAR();
      f32x4 a0 = {0.f, 0.f, 0.f, 0.f}, a1 = a0;
      mm16v2<false>(Pm + ti * 16 * 68, 68, V + cb, 68, 16 * (ti + 1), a0, a1, lane);
      mm16v2<true>(Q + ti * 16 * 36, 36, S + cb * 36, 36, 32, a0, a1, lane);
#pragma unroll
      for (int r = 0; r < 4; ++r) { const int i = ti * 16 + 4 * lq + r, j = cb + 2 * li; *(f32x2*)(O + i * 68 + j) = (f32x2){a0[r], a1[r]}; } }
    LBAR();
    { const int r = tid >> 3, c8 = (tid & 7) * 8; float v[8]; float ss = 0.f;
#pragma unroll
      for (int j = 0; j < 8; ++j) { v[j] = ((j < 4) ? (*(const f32x4*)(O + r * 68 + c8))[j & 3] : (*(const f32x4*)(O + r * 68 + c8 + 4))[j & 3]); ss += v[j] * v[j]; }
      ss += __shfl_xor(ss, 1); ss += __shfl_xor(ss, 2); ss += __shfl_xor(ss, 4);
      const float rs = rsqrtf(ss * (1.f / 64.f) + EPSF); float gt[8]; unpack8(*(const u32x4*)(z + (size_t)r * NZ + ZC_AR + h * 64 + c8), gt);
      const float* ng = c.in(I_GLA_NORM) + l * 64 + c8;
#pragma unroll
      for (int j = 0; j < 8; ++j) v[j] = v[j] * rs * ng[j] * siluf(gt[j]);
      *(u32x4*)(z + (size_t)r * NZ + ZC_AV + h * 64 + c8) = pack8(v); }
    LBAR();
}

template <bool OUT>
static __device__ __forceinline__ void s5_item(const Ctx& c, unsigned char* smb, int item) {
    const int tid = ltid(), lane = tid & 63, wv = tid >> 6, l = c.layer; const int b = item >> 5, n = item & 31; const int tok0 = b * SEQL + n * 64;
    bf16_t* UY = (bf16_t*)smb;
    float* ST = (float*)(smb + 33792) + wv * 2112;
    bf16_t* z = c.w<bf16_t>(WS_Z) + (size_t)tok0 * NZ;
    { u32x4 ru[4];
#pragma unroll
      for (int i = 0; i < 4; ++i) { const int e = tid + i * NTHR; ru[i] = *(const u32x4*)(z + (size_t)(e >> 5) * NZ + ZC_SU + (e & 31) * 8); }
#pragma unroll
      for (int i = 0; i < 4; ++i) { const int e = tid + i * NTHR; *(u32x4*)(UY + (e >> 5) * 264 + (e & 31) * 8) = ru[i]; } }
    LBAR();
    const float* A = c.w<float>(WS_S5A); const int hh = lane & 15, q = lane >> 4;
    for (int gi = 0; gi < 2; ++gi) {
        const int g = wv + 8 * gi, gp = g * 64 + lane;
        const float ar = A[gp], ai = A[1024 + gp];
        bf16x8 BF[8];
        { const bf16_t* BB = c.w<bf16_t>(WS_S5BB) + ((size_t)(g * 8) * 64 + lane) * 8;
#pragma unroll
          for (int ct = 0; ct < 8; ++ct) BF[ct] = *(const bf16x8*)(BB + (size_t)ct * 512); }
        f32x2* Ep = (f32x2*)c.w<float>(WS_S5E) + ((size_t)((b * 16 + g) * 32 + n)) * 64 + lane;
        float xr = 0.f, xi = 0.f;
        float C2[32]; float dsk = 0.f;
        if (OUT) { const f32x2 s0 = *Ep; xr = s0[0]; xi = s0[1];
            const float* cre = c.in(I_S5_CRE) + (size_t)l * 16384 + (size_t)(g * 16 + hh) * 64; const float* cim = c.in(I_S5_CIM) + (size_t)l * 16384 + (size_t)(g * 16 + hh) * 64;
#pragma unroll
            for (int i4 = 0; i4 < 8; ++i4) {
                const f32x4 cv = (q < 2) ? *(const f32x4*)(cre + 32 * q + 4 * i4) : *(const f32x4*)(cim + 32 * (q - 2) + 4 * i4); const float sg = (q < 2) ? 1.f : -1.f;
                C2[4 * i4] = sg * cv[0]; C2[4 * i4 + 1] = sg * cv[1]; C2[4 * i4 + 2] = sg * cv[2]; C2[4 * i4 + 3] = sg * cv[3]; }
            dsk = c.in(I_S5_D)[l * 256 + g * 16 + hh]; }
        for (int sub = 0; sub < 4; ++sub) {
            { const bf16x8 af = *(const bf16x8*)(UY + (sub * 16 + hh) * 264 + g * 16 + 8 * (q & 1));
#pragma unroll
              for (int ct = 0; ct < 8; ++ct) { f32x4 bu = {0.f, 0.f, 0.f, 0.f}; bu = __builtin_amdgcn_mfma_f32_16x16x32_bf16(af, BF[ct], bu, 0, 0, 0);
#pragma unroll
                  for (int r = 0; r < 4; ++r) ST[(4 * q + r) * 132 + ct * 16 + hh] = bu[r]; } }
            asm volatile("s_waitcnt lgkmcnt(0)" ::: "memory");
#pragma unroll 4
            for (int s = 0; s < 16; ++s) { const float bur = ST[s * 132 + lane], bui = ST[s * 132 + 64 + lane];
                const float nr = ar * xr - ai * xi + bur, ni = ar * xi + ai * xr + bui; xr = nr; xi = ni;
                if (OUT) { ST[s * 132 + lane] = xr; ST[s * 132 + 64 + lane] = xi; } }
            if (OUT) {
                asm volatile("s_waitcnt lgkmcnt(0)" ::: "memory");
                f32x4 acc = {0.f, 0.f, 0.f, 0.f}, acc2 = {0.f, 0.f, 0.f, 0.f};
#pragma unroll
                for (int i4 = 0; i4 < 8; ++i4) { const f32x4 sv = *(const f32x4*)(ST + hh * 132 + 32 * q + 4 * i4);
                    if (i4 & 1) { acc2 = __builtin_amdgcn_mfma_f32_16x16x4f32(sv[0], C2[4 * i4], acc2, 0, 0, 0); acc2 = __builtin_amdgcn_mfma_f32_16x16x4f32(sv[1], C2[4 * i4 + 1], acc2, 0, 0, 0);
                                  acc2 = __builtin_amdgcn_mfma_f32_16x16x4f32(sv[2], C2[4 * i4 + 2], acc2, 0, 0, 0); acc2 = __builtin_amdgcn_mfma_f32_16x16x4f32(sv[3], C2[4 * i4 + 3], acc2, 0, 0, 0); }
                    else        { acc = __builtin_amdgcn_mfma_f32_16x16x4f32(sv[0], C2[4 * i4], acc, 0, 0, 0); acc = __builtin_amdgcn_mfma_f32_16x16x4f32(sv[1], C2[4 * i4 + 1], acc, 0, 0, 0);
                                  acc = __builtin_amdgcn_mfma_f32_16x16x4f32(sv[2], C2[4 * i4 + 2], acc, 0, 0, 0); acc = __builtin_amdgcn_mfma_f32_16x16x4f32(sv[3], C2[4 * i4 + 3], acc, 0, 0, 0); } }
                acc += acc2;
#pragma unroll
                for (int r = 0; r < 4; ++r) { const int t = sub * 16 + 4 * q + r; bf16_t* p = UY + t * 264 + g * 16 + hh; const float y = acc[r] + dsk * bf2f(*p); *p = (bf16_t)f2bf(gelu_tanh(y)); }
            }
            asm volatile("s_waitcnt lgkmcnt(0)" ::: "memory");
        }
        if (!OUT) *Ep = (f32x2){xr, xi};
    }
    if (OUT) {
        LBAR();
        const bf16_t* Wg = c.w<bf16_t>(WS_WGLU); f32x4 acc[4][2];
#pragma unroll
        for (int a = 0; a < 4; ++a) { acc[a][0] = (f32x4){0.f, 0.f, 0.f, 0.f}; acc[a][1] = (f32x4){0.f, 0.f, 0.f, 0.f}; }
#pragma unroll 2
        for (int k = 0; k < 256; k += 32) {
            const bf16x8 b0 = *(const bf16x8*)(Wg + (size_t)(wv * 32 + hh) * 256 + k + 8 * q), b1 = *(const bf16x8*)(Wg + (size_t)(wv * 32 + 16 + hh) * 256 + k + 8 * q);
#pragma unroll
            for (int a = 0; a < 4; ++a) { const bf16x8 av = *(const bf16x8*)(UY + (a * 16 + hh) * 264 + k + 8 * q);
                acc[a][0] = __builtin_amdgcn_mfma_f32_16x16x32_bf16(av, b0, acc[a][0], 0, 0, 0); acc[a][1] = __builtin_amdgcn_mfma_f32_16x16x32_bf16(av, b1, acc[a][1], 0, 0, 0); }
        }
        const float* bg = c.in(I_S5_BGLU) + l * 256;
#pragma unroll
        for (int a = 0; a < 4; ++a)
#pragma unroll
            for (int jn = 0; jn < 2; ++jn) { const int col = wv * 32 + jn * 16 + hh; const float bb = bg[col];
#pragma unroll
                for (int r = 0; r < 4; ++r) { const int row = a * 16 + 4 * q + r; const float y = bf2f(UY[row * 264 + col]);
                    z[(size_t)row * NZ + ZC_SU + col] = (bf16_t)f2bf(y * sigm(acc[a][jn][r] + bb)); } }
    }
    LBAR();
}

static __device__ __forceinline__ void scan_tasks(const Ctx& c, int wid, int nworkers) {
    const int gt = wid * NTHR + ltid(), gs = nworkers * NTHR;
    constexpr int T_RET = 32 * 1024, T_GLA = 32 * 512, T_S5 = 8192;
    for (int t = gt; t < T_RET + T_GLA + T_S5; t += gs) {
        if (t < T_RET) { const int bh = t >> 10, e4 = (t & 1023) * 4; const int h = bh & 3; const float a = __expf(64.f * ret_loggamma(h));
            float* p = c.w<float>(WS_RDS) + (size_t)bh * 32 * 4096 + e4; f32x4 S = {0.f, 0.f, 0.f, 0.f}; asm volatile("" : "+v"(S));
#pragma unroll 1
            for (int hf = 0; hf < 8; ++hf) { f32x4 inc[4];
#pragma unroll
                for (int n = 0; n < 4; ++n) inc[n] = *(const f32x4*)(p + (size_t)(hf * 4 + n) * 4096);
#pragma unroll
                for (int n = 0; n < 4; ++n) { *(f32x4*)(p + (size_t)(hf * 4 + n) * 4096) = S; S = S * a + inc[n]; } } }
        else if (t < T_RET + T_GLA) { const int u = t - T_RET; const int bh = u >> 9, e4 = (u & 511) * 4; const int dk = e4 & 31;
            float* p = c.w<float>(WS_ADS) + (size_t)bh * 32 * 2048 + e4; const float* dec = c.w<float>(WS_GLDEC) + (size_t)bh * 32 * 32 + dk; f32x4 S = {0.f, 0.f, 0.f, 0.f}; asm volatile("" : "+v"(S));
#pragma unroll 1
            for (int hf = 0; hf < 8; ++hf) { f32x4 inc[4]; f32x4 av[4];
#pragma unroll
                for (int n = 0; n < 4; ++n) { inc[n] = *(const f32x4*)(p + (size_t)(hf * 4 + n) * 2048); av[n] = *(const f32x4*)(dec + (hf * 4 + n) * 32); }
#pragma unroll
                for (int n = 0; n < 4; ++n) { *(f32x4*)(p + (size_t)(hf * 4 + n) * 2048) = S; S = S * av[n] + inc[n]; } } }
        else { const int u = t - T_RET - T_GLA; const int bg = u >> 6, pp = u & 63; const int g = bg & 15; const float* A = c.w<float>(WS_S5A); const float ar = A[2048 + g * 64 + pp], ai = A[3072 + g * 64 + pp];
            f32x2* p = (f32x2*)c.w<float>(WS_S5E) + (size_t)bg * 32 * 64 + pp; float xr = 0.f, xi = 0.f; asm volatile("" : "+v"(xr), "+v"(xi));
#pragma unroll 1
            for (int hf = 0; hf < 8; ++hf) { f32x2 ev[4];
#pragma unroll
                for (int n = 0; n < 4; ++n) ev[n] = p[(size_t)(hf * 4 + n) * 64];
#pragma unroll
                for (int n = 0; n < 4; ++n) { p[(size_t)(hf * 4 + n) * 64] = (f32x2){xr, xi}; const float nr = ar * xr - ai * xi + ev[n][0], ni = ar * xi + ai * xr + ev[n][1]; xr = nr; xi = ni; } } }
    }
}

static __device__ __forceinline__ void phase_m1(const Ctx& c, unsigned char* smb) {
    float* sm = (float*)smb;
    for (int it = c.bid; it < 1024 + 256; it += c.G) {
        if (it < 1024) gdn_m1(c, sm, it);
        else s5_item<false>(c, smb, it - 1024);
    }
}
static __device__ __forceinline__ void phase_m2(const Ctx& c, unsigned char* smb) {
    const int nA = c.G / 2; float* sm = (float*)smb;
    if (c.bid < nA) { for (int it = c.bid; it < 128; it += nA) { gdn_m2(c, sm, it); LBAR(); } }
    else { for (int it = c.bid - nA; it < 2048; it += c.G - nA) { if (it < 1024) ret_m1(c, sm, it); else gla_m1(c, sm, it - 1024); } }
}
static __device__ __forceinline__ void phase_m2b(const Ctx& c) { scan_tasks(c, c.bid, c.G); for (int it = c.bid; it < 1024; it += c.G) gdn_m3(c, it); }
static __device__ __forceinline__ void phase_m3(const Ctx& c, unsigned char* smb) {
    float* sm = (float*)smb;
    for (int it = c.bid; it < 256 + 2048; it += c.G) {
        if (it < 256) s5_item<true>(c, smb, it);
        else if (it < 1280) ret_m3(c, sm, it - 256);
        else if (it < 2304) gla_m3(c, sm, it - 1280);
    }
}
static __device__ __forceinline__ void phase_pb(const Ctx& c, const int wid, const int nw) {
    const float* p = c.in(I_P) + (size_t)c.layer * MTOK * PLED; bf16_t* pb = c.w<bf16_t>(WS_PB);
    const int tid = ltid();
    for (size_t e = (size_t)(wid * NTHR + tid) * 8; e < (size_t)MTOK * PLED; e += (size_t)nw * NTHR * 8) {
        const f32x4 a = __builtin_nontemporal_load((const f32x4*)(p + e)), b = __builtin_nontemporal_load((const f32x4*)(p + e + 4)); float v[8] = {a[0], a[1], a[2], a[3], b[0], b[1], b[2], b[3]}; *(u32x4*)(pb + e) = pack8(v); }
}
static __device__ __forceinline__ void phase_final(const Ctx& c) {
    const int tid = ltid(), lane = tid & 63; const float* rowss = c.w<float>(WS_ROWSS) + (size_t)6 * MTOK; const float* g = c.in(I_NFINAL); float* out = c.out();
    for (int row = c.bid * 8 + (tid >> 6); row < MTOK; row += c.G * 8) { const float rs = row_rs(rowss, row);
#pragma unroll
        for (int i = 0; i < 4; ++i) { float* p = out + (size_t)row * DM + i * 256 + lane * 4; const f32x4 v = __builtin_nontemporal_load((const f32x4*)p), gg = *(const f32x4*)(g + i * 256 + lane * 4); __builtin_nontemporal_store(v * rs * gg, (f32x4*)p); } }
}

#define XB_TMO      128
#define XB_XCNT(j)  (256  + 64 * (j))
#define XB_XSUB(j)  (1280 + 64 * (j))
#define XB_XGEN(j)  (2304 + 64 * (j))
#define XB_TOP      3328
#define XB_TOPGEN   3392
#define XCD_BAR_WORDS 3456
#define XB_SPIN_CAP (1u << 18)
__device__ __forceinline__ unsigned xb_ld(unsigned* p)              { return __hip_atomic_load(p, __ATOMIC_RELAXED, __HIP_MEMORY_SCOPE_AGENT); }
__device__ __forceinline__ unsigned xb_add(unsigned* p, unsigned v) { return __hip_atomic_fetch_add(p, v, __ATOMIC_RELAXED, __HIP_MEMORY_SCOPE_AGENT); }
__device__ __forceinline__ unsigned xb_xcc_id() { return (unsigned)__builtin_amdgcn_s_getreg((3 << 11) | 20) & 0xFu; }
#define XB_SPIN(cond, bar) do { unsigned _sp = 0; while (cond) { __builtin_amdgcn_s_sleep(1); \
    if ((++_sp & 255u) == 0u) { if (xb_ld(&(bar)[XB_TMO])) break; if (_sp > XB_SPIN_CAP) { atomicAdd(&(bar)[XB_TMO], 1u); break; } } } } while (0)
struct XcdBarrier { unsigned* bar; unsigned x; volatile LAS unsigned* st; };
__device__ __forceinline__ XcdBarrier xcd_barrier_post(unsigned* bar, volatile LAS unsigned* st) {
    XcdBarrier b; b.bar = bar; b.x = xb_xcc_id(); b.st = st;
    if (threadIdx.x == 0) (void)xb_add(&bar[XB_XCNT(b.x)], 1u);
    return b;
}
__device__ __forceinline__ void xcd_barrier_complete(unsigned* bar, unsigned x, unsigned& nloc, unsigned& nx) {
    const unsigned G = gridDim.x * gridDim.y * gridDim.z;
    unsigned sum, cnt, mine, sp = 0u;
    for (;;) {
        sum = 0u; cnt = 0u; mine = 0u;
#pragma unroll
        for (unsigned j = 0; j < 16; ++j) { const unsigned c = xb_ld(&bar[XB_XCNT(j)]); sum += c; cnt += (c > 0u) ? 1u : 0u; mine = (j == x) ? c : mine; }
        if (sum == G) break;
        __builtin_amdgcn_s_sleep(1);
        if ((++sp & 255u) == 0u) { if (xb_ld(&bar[XB_TMO])) break; if (sp > XB_SPIN_CAP) { atomicAdd(&bar[XB_TMO], 1u); break; } }
    }
    nloc = mine > 0u ? mine : 1u; nx = cnt > 0u ? cnt : 1u;
}
__device__ __forceinline__ void xcd_barrier(const XcdBarrier& b) {
    asm volatile("s_waitcnt vmcnt(0)" ::: "memory");
    __syncthreads();
    if (threadIdx.x == 0) {
        unsigned* bar = b.bar;
        __builtin_amdgcn_s_waitcnt(0);
        unsigned nloc = b.st[0], nx = b.st[1];
        if (nloc == 0u) { xcd_barrier_complete(bar, b.x, nloc, nx); b.st[0] = nloc; b.st[1] = nx; }
        const unsigned old = xb_add(&bar[XB_XSUB(b.x)], 1u);
        const unsigned gen = old / nloc;
        if (old + 1u == (gen + 1u) * nloc) {
            __builtin_amdgcn_fence(__ATOMIC_RELEASE, "agent");
            asm volatile("s_waitcnt vmcnt(0)" ::: "memory");
            const unsigned og = xb_add(&bar[XB_TOP], 1u);
            const unsigned tg = og / nx;
            if (og + 1u == (tg + 1u) * nx) xb_add(&bar[XB_TOPGEN], 1u);
            else XB_SPIN(xb_ld(&bar[XB_TOPGEN]) == tg, bar);
            __builtin_amdgcn_fence(__ATOMIC_ACQUIRE, "agent");
            xb_add(&bar[XB_XGEN(b.x)], 1u);
            asm volatile("s_waitcnt vmcnt(0)" ::: "memory");
        } else {
            XB_SPIN(xb_ld(&bar[XB_XGEN(b.x)]) == gen, bar);
            __builtin_amdgcn_fence(__ATOMIC_ACQUIRE, "agent");
            asm volatile("s_waitcnt vmcnt(0)" ::: "memory");
        }
    }
    __syncthreads();
}

__global__ void __launch_bounds__(NTHR) mega_fwd(Params P) {
    extern __shared__ __attribute__((aligned(16))) unsigned char lds_raw[];
    cg::grid_group grid = cg::this_grid();
    LAS unsigned char* lds = (LAS unsigned char*)lds_raw;
    Ctx c; c.refresh(); c.layer = 0;
    volatile LAS unsigned* bst = (volatile LAS unsigned*)(lds + LDS_BYTES - 16);
    if (threadIdx.x == 0) { bst[0] = 0u; bst[1] = 0u; }
    __syncthreads();
    (void)xcd_barrier_post((unsigned*)(c.ws + WS_BAR), bst);
    bool first_sync = true;
#define GSYNC() do { if (first_sync) { grid.sync(); first_sync = false; } else { c.refresh(); XcdBarrier xb_; xb_.bar = (unsigned*)(c.ws + WS_BAR); xb_.x = xb_xcc_id(); xb_.st = bst; xcd_barrier(xb_); } c.refresh(); } while (0)
    { constexpr int l = 0; c.layer = l;
        if (l == 0) phase_conv(c, (float*)lds_raw, 0, c.bid, c.G, 0, CT_ALL, true); else phase_conv(c, (float*)lds_raw, 1, c.bid, c.G, CT_EARLY, CT_ALL, false);
        GSYNC();
        { const bf16_t* hin = (l == 0) ? c.w<bf16_t>(WS_HB) : (const bf16_t*)c.out(); pg8::Gemm g{hin, c.w<bf16_t>(WS_WIN), MTOK, NZ, DM, DM}; pg8::StaticOrder S; S.init(MTOK, NZ, c.G, c.bid);
          pg8::EpiZ E{c.w<bf16_t>(WS_Z), c.w<float>(WS_ROWSS) + (size_t)(3 * l) * MTOK};
          pg8::gemm_phase<pg8::EpiZ>(lds, g, S, E);
          small_proj(c, (l == 0) ? c.w<bf16_t>(WS_HB) : (const bf16_t*)c.out(), c.w<float>(WS_ROWSS) + (size_t)(3 * l) * MTOK); }
        GSYNC();
        phase_m1(c, lds_raw);
        GSYNC();
        phase_m2(c, lds_raw);
        GSYNC();
        phase_m2b(c);
        GSYNC();
        phase_m3(c, lds_raw);
        GSYNC();
        { pg8::Gemm g{c.w<bf16_t>(WS_Z), c.w<bf16_t>(WS_WOUT), MTOK, DM, DM, NZ}; pg8::StaticOrder S; S.init(MTOK, DM, c.G, c.bid);
          pg8::EpiRes E{l == 0 ? c.in(I_X) : (const float*)nullptr, (const bf16_t*)c.out(), c.w<bf16_t>(WS_HB), c.w<float>(WS_ROWSS) + (size_t)(3 * l + 1) * MTOK};
          pg8::gemm_phase<pg8::EpiRes>(lds, g, S, E); }
        GSYNC();
        { pg8::Gemm g{c.w<bf16_t>(WS_HB), c.w<bf16_t>(WS_WUP), MTOK, NUP, DM, DM}; pg8::StaticOrder S; S.init(MTOK, NUP, c.G, c.bid);
          pg8::EpiAct E{c.w<bf16_t>(WS_ACT), c.w<float>(WS_ROWSS) + (size_t)(3 * l + 1) * MTOK};
          pg8::gemm_phase<pg8::EpiAct>(lds, g, S, E);
          { const int hG = c.G / 2; if (c.bid >= hG) { phase_pb(c, c.bid - hG, c.G - hG); if (l == 0) phase_conv(c, (float*)lds_raw, 1, c.bid - hG, c.G - hG, 0, CT_EARLY, true); } } }
        GSYNC();
        { pg8::Gemm g{c.w<bf16_t>(WS_ACT), c.w<bf16_t>(WS_WDN), MTOK, DM, FF, FF}; pg8::StaticOrder S; S.init(MTOK, DM, c.G, c.bid);
          pg8::EpiRes E{(const float*)nullptr, c.w<bf16_t>(WS_HB), c.w<bf16_t>(WS_HB), c.w<float>(WS_ROWSS) + (size_t)(3 * l + 2) * MTOK};
          pg8::gemm_phase<pg8::EpiRes>(lds, g, S, E);
        }
        GSYNC();
        { pg8::StaticOrder S; S.init(MTOK, DM, c.G, c.bid);
          pg8::Gemm g1{c.w<bf16_t>(WS_PB), c.w<bf16_t>(WS_WPP), MTOK, DM, PLED, PLED};
          pg8::EpiTmp E1{c.w<bf16_t>(WS_TMP)};
          pg8::gemm_phase<pg8::EpiTmp>(lds, g1, S, E1);
          pg8::Gemm g2{c.w<bf16_t>(WS_HB), c.w<bf16_t>(WS_WPG), MTOK, DM, DM, DM};
          pg8::EpiPle E2{c.w<bf16_t>(WS_TMP), c.w<bf16_t>(WS_HB), (l == 0) ? (bf16_t*)c.out() : c.w<bf16_t>(WS_HB2), c.w<float>(WS_ROWSS) + (size_t)(3 * l + 2) * MTOK, c.w<float>(WS_ROWSS) + (size_t)(3 * l + 3) * MTOK, (l == 0) ? (float*)nullptr : c.out()};
          pg8::gemm_phase<pg8::EpiPle>(lds, g2, S, E2); }
        GSYNC();
        }
    { constexpr int l = 1; c.layer = l;
        if (l == 0) phase_conv(c, (float*)lds_raw, 0, c.bid, c.G, 0, CT_ALL, true); else phase_conv(c, (float*)lds_raw, 1, c.bid, c.G, CT_EARLY, CT_ALL, false);
        GSYNC();
        { const bf16_t* hin = (l == 0) ? c.w<bf16_t>(WS_HB) : (const bf16_t*)c.out(); pg8::Gemm g{hin, c.w<bf16_t>(WS_WIN), MTOK, NZ, DM, DM}; pg8::StaticOrder S; S.init(MTOK, NZ, c.G, c.bid);
          pg8::EpiZ E{c.w<bf16_t>(WS_Z), c.w<float>(WS_ROWSS) + (size_t)(3 * l) * MTOK};
          pg8::gemm_phase<pg8::EpiZ>(lds, g, S, E);
          small_proj(c, (l == 0) ? c.w<bf16_t>(WS_HB) : (const bf16_t*)c.out(), c.w<float>(WS_ROWSS) + (size_t)(3 * l) * MTOK); }
        GSYNC();
        phase_m1(c, lds_raw);
        GSYNC();
        phase_m2(c, lds_raw);
        GSYNC();
        phase_m2b(c);
        GSYNC();
        phase_m3(c, lds_raw);
        GSYNC();
        { pg8::Gemm g{c.w<bf16_t>(WS_Z), c.w<bf16_t>(WS_WOUT), MTOK, DM, DM, NZ}; pg8::StaticOrder S; S.init(MTOK, DM, c.G, c.bid);
          pg8::EpiRes E{l == 0 ? c.in(I_X) : (const float*)nullptr, (const bf16_t*)c.out(), c.w<bf16_t>(WS_HB), c.w<float>(WS_ROWSS) + (size_t)(3 * l + 1) * MTOK};
          pg8::gemm_phase<pg8::EpiRes>(lds, g, S, E); }
        GSYNC();
        { pg8::Gemm g{c.w<bf16_t>(WS_HB), c.w<bf16_t>(WS_WUP), MTOK, NUP, DM, DM}; pg8::StaticOrder S; S.init(MTOK, NUP, c.G, c.bid);
          pg8::EpiAct E{c.w<bf16_t>(WS_ACT), c.w<float>(WS_ROWSS) + (size_t)(3 * l + 1) * MTOK};
          pg8::gemm_phase<pg8::EpiAct>(lds, g, S, E);
          { const int hG = c.G / 2; if (c.bid >= hG) { phase_pb(c, c.bid - hG, c.G - hG); if (l == 0) phase_conv(c, (float*)lds_raw, 1, c.bid - hG, c.G - hG, 0, CT_EARLY, true); } } }
        GSYNC();
        { pg8::Gemm g{c.w<bf16_t>(WS_ACT), c.w<bf16_t>(WS_WDN), MTOK, DM, FF, FF}; pg8::StaticOrder S; S.init(MTOK, DM, c.G, c.bid);
          pg8::EpiRes E{(const float*)nullptr, c.w<bf16_t>(WS_HB), c.w<bf16_t>(WS_HB), c.w<float>(WS_ROWSS) + (size_t)(3 * l + 2) * MTOK};
          pg8::gemm_phase<pg8::EpiRes>(lds, g, S, E);
        }
        GSYNC();
        { pg8::StaticOrder S; S.init(MTOK, DM, c.G, c.bid);
          pg8::Gemm g1{c.w<bf16_t>(WS_PB), c.w<bf16_t>(WS_WPP), MTOK, DM, PLED, PLED};
          pg8::EpiTmp E1{c.w<bf16_t>(WS_TMP)};
          pg8::gemm_phase<pg8::EpiTmp>(lds, g1, S, E1);
          pg8::Gemm g2{c.w<bf16_t>(WS_HB), c.w<bf16_t>(WS_WPG), MTOK, DM, DM, DM};
          pg8::EpiPle E2{c.w<bf16_t>(WS_TMP), c.w<bf16_t>(WS_HB), (l == 0) ? (bf16_t*)c.out() : c.w<bf16_t>(WS_HB2), c.w<float>(WS_ROWSS) + (size_t)(3 * l + 2) * MTOK, c.w<float>(WS_ROWSS) + (size_t)(3 * l + 3) * MTOK, (l == 0) ? (float*)nullptr : c.out()};
          pg8::gemm_phase<pg8::EpiPle>(lds, g2, S, E2); }
        GSYNC();
        }
    phase_final(c);
}

extern "C" void kernel_launch(void* const* d_in, const int* in_sizes, int n_in, void* d_out, int out_size, void* d_ws, size_t ws_size, hipStream_t stream) {
    static int grid_blocks = 0;
    if (grid_blocks == 0) {
        if (n_in != 31 || ws_size < WS_TOTAL) { fprintf(stderr, "kernel_launch: n_in %d ws %zu (need %zu)\n", n_in, ws_size, (size_t)WS_TOTAL); grid_blocks = -1; return; }
        int dev = 0, cus = 0, per_cu = 0;
        hipGetDevice(&dev); hipDeviceGetAttribute(&cus, hipDeviceAttributeMultiprocessorCount, dev);
        hipFuncSetAttribute((const void*)mega_fwd, hipFuncAttributeMaxDynamicSharedMemorySize, LDS_BYTES);
        hipOccupancyMaxActiveBlocksPerMultiprocessor(&per_cu, (const void*)mega_fwd, NTHR, LDS_BYTES);
        if (per_cu < 1) { fprintf(stderr, "kernel_launch: occupancy query says %d blocks/CU\n", per_cu); per_cu = 1; }
        grid_blocks = cus * 1;
        (void)hipGetLastError();
    }
    if (grid_blocks < 0) return;
    Params p{};
    for (int i = 0; i < 31; ++i) p.in[i] = (const float*)d_in[i];
    p.out = (float*)d_out; p.ws = (unsigned char*)d_ws;
    (void)hipMemsetAsync((unsigned char*)d_ws + WS_BAR, 0, 16384, stream);
    void* args[] = {&p};
    hipError_t e = hipLaunchCooperativeKernel((const void*)mega_fwd, dim3(grid_blocks), dim3(NTHR), args, LDS_BYTES, stream);
    if (e != hipSuccess) fprintf(stderr, "cooperative launch failed: %s (grid %d)\n", hipGetErrorString(e), grid_blocks);
}
```
